# Optimizing an MI355X kernel written in HIP

```python
import math
import jax, jax.numpy as jnp
from jax import lax
import numpy as np

D_MODEL = 1024
BATCH = 8
SEQ = 2048
DEPTH = 1

GRID_W = 64
CTX_LEN = 256
NA_HEADS = 8
NA_HEAD_DIM = 64
NA_KH = 8
NA_KW = 16
NA_SCALE = NA_HEAD_DIM ** -0.5
DN_HEADS = 8
DN_HEAD_DIM = 64
DN_CONV = 5
DN_CHUNK = 64
ROPE_THETA = 10000.0
N_EXPERTS = 32
TOP_K = 4
D_EXPERT = 1024
SWIGLU_LIMIT = 7.0
SWIGLU_ALPHA = 1.702
MOE_BLOCK = 128
NORM_EPS = 1e-6
NEG_INF = -1e30
NA_WIDTH = NA_HEADS * NA_HEAD_DIM
DN_WIDTH = DN_HEADS * DN_HEAD_DIM
IN_SPLITS = (NA_WIDTH, NA_WIDTH, NA_WIDTH, 3 * DN_WIDTH, DN_WIDTH, 2 * DN_HEADS, 2 * DN_HEADS, D_MODEL, D_MODEL)
D_IN = sum(IN_SPLITS)
IN_OFFSETS = tuple(int(o) for o in np.cumsum(IN_SPLITS)[:-1])

kernel_name = 'hybrid_na_gdn_moe_dit_block'


def rmsnorm(x, w):
    xf = x.astype(jnp.float32)
    y = xf * lax.rsqrt(jnp.mean(xf * xf, axis=-1, keepdims=True) + NORM_EPS)
    return (y * w.astype(jnp.float32)).astype(x.dtype)


def modulate(h, shift, scale):
    return h * (1.0 + scale) + shift


def to_heads(t, heads):
    b, t_len, _ = t.shape
    return t.reshape(b, t_len, heads, -1).transpose(0, 2, 1, 3)


def merge_heads(o):
    b, h, t_len, d = o.shape
    return o.transpose(0, 2, 1, 3).reshape(b, t_len, h * d)


def l2norm(x):
    return x * lax.rsqrt(jnp.sum(x * x, axis=-1, keepdims=True) + NORM_EPS)


def centred_dwconv(x, w):
    taps, ch = w.shape
    return lax.conv_general_dilated(x, w[:, None, :].astype(x.dtype), window_strides=(1,),
                                    padding=[(taps // 2, taps // 2)],
                                    dimension_numbers=('NWC', 'WIO', 'NWC'), feature_group_count=ch)


def axial_rope(x, t_len):
    t = jnp.arange(t_len)
    row = (t // GRID_W).astype(jnp.float32)
    col = (t % GRID_W).astype(jnp.float32)
    half = x.shape[-1] // 2
    n_axis = half // 2
    freqs = ROPE_THETA ** (-jnp.arange(n_axis, dtype=jnp.float32) / n_axis)
    ang = jnp.concatenate([row[:, None] * freqs, col[:, None] * freqs], axis=-1)
    cos, sin = jnp.cos(ang), jnp.sin(ang)
    x1, x2 = x[..., :half], x[..., half:]
    return jnp.concatenate([x1 * cos - x2 * sin, x1 * sin + x2 * cos], axis=-1)


def neighborhood_attention(q, k, v, k_ctx, v_ctx, rpb, rows):
    b, h, t_len, dh = q.shape
    kh = min(NA_KH, rows)
    r = jnp.arange(rows)
    row_idx = jnp.clip(r - kh // 2, 0, rows - kh)[:, None] + jnp.arange(kh)[None, :]
    col = jnp.arange(GRID_W)
    col_start = jnp.clip(col - NA_KW // 2, 0, GRID_W - NA_KW)
    col_mask = (col[None, :] >= col_start[:, None]) & (col[None, :] < col_start[:, None] + NA_KW)
    dr_idx = row_idx - r[:, None] + NA_KH - 1
    dc_idx = jnp.clip(col[None, :] - col[:, None] + NA_KW - 1, 0, 2 * NA_KW - 2)
    bias = rpb[:, dr_idx[:, None, :, None], dc_idx[None, :, None, :]].astype(jnp.float32)
    qg = q.reshape(b, h, rows, GRID_W, dh)
    kg = k.reshape(b, h, rows, GRID_W, dh)[:, :, row_idx]
    vg = v.reshape(b, h, rows, GRID_W, dh)[:, :, row_idx]
    s_lat = jnp.einsum('bhrqd,bhrjkd->bhrqjk', qg, kg).astype(jnp.float32) * NA_SCALE + bias
    s_lat = jnp.where(col_mask[:, None, :], s_lat, NEG_INF)
    s_ctx = jnp.einsum('bhrqd,bhld->bhrql', qg, k_ctx).astype(jnp.float32) * NA_SCALE
    n_lat = kh * GRID_W
    s = jnp.concatenate([s_lat.reshape(b, h, rows, GRID_W, n_lat), s_ctx], axis=-1)
    p = jax.nn.softmax(s, axis=-1).astype(v.dtype)
    p_lat = p[..., :n_lat].reshape(b, h, rows, GRID_W, kh, GRID_W)
    o = (jnp.einsum('bhrqjk,bhrjkd->bhrqd', p_lat, vg)
         + jnp.einsum('bhrql,bhld->bhrqd', p[..., n_lat:], v_ctx))
    return merge_heads(o.reshape(b, h, t_len, dh))


def context_attention(q, k, v):
    s = jnp.einsum('bhqd,bhkd->bhqk', q, k).astype(jnp.float32) * NA_SCALE
    p = jax.nn.softmax(s, axis=-1).astype(v.dtype)
    return merge_heads(jnp.einsum('bhqk,bhkd->bhqd', p, v))


def gated_delta_chunked(q, k, v, g, beta, s0):
    b, h, t_len, dk = q.shape
    dv = v.shape[-1]
    n = t_len // DN_CHUNK
    chunk = lambda t: t.reshape(b, h, n, DN_CHUNK, *t.shape[3:])
    qc, kc, vc, bc = chunk(q * dk ** -0.5), chunk(k), chunk(v), chunk(beta)
    gcum = jnp.cumsum(chunk(g), axis=-1)
    incl = jnp.tril(jnp.ones((DN_CHUNK, DN_CHUNK), dtype=bool))
    strict = jnp.tril(jnp.ones((DN_CHUNK, DN_CHUNK), dtype=bool), -1)
    diff = gcum[..., :, None] - gcum[..., None, :]
    decay = jnp.where(incl, jnp.exp(jnp.where(incl, diff, 0.0)), 0.0)
    kb = kc * bc[..., None]
    a = jnp.where(strict, jnp.einsum('bhnid,bhnjd->bhnij', kb, kc) * decay, 0.0)
    eye = jnp.eye(DN_CHUNK, dtype=a.dtype)
    t_inv = lax.linalg.triangular_solve(a + eye, jnp.broadcast_to(eye, a.shape), left_side=True,
                                        lower=True, unit_diagonal=True)
    u = jnp.einsum('bhnij,bhnjd->bhnid', t_inv, vc * bc[..., None])
    w = jnp.einsum('bhnij,bhnjd->bhnid', t_inv, kb * jnp.exp(gcum)[..., None])
    qk = jnp.einsum('bhnid,bhnjd->bhnij', qc, kc) * decay
    q_dec = qc * jnp.exp(gcum)[..., None]
    g_last = gcum[..., -1]
    k_tail = kc * jnp.exp(g_last[..., None] - gcum)[..., None]

    def step(s, xs):
        u_n, w_n, qk_n, qd_n, kt_n, gl_n = xs
        v_new = u_n - jnp.einsum('bhid,bhde->bhie', w_n, s)
        o_n = jnp.einsum('bhid,bhde->bhie', qd_n, s) + jnp.einsum('bhij,bhje->bhie', qk_n, v_new)
        s = s * jnp.exp(gl_n)[..., None, None] + jnp.einsum('bhid,bhie->bhde', kt_n, v_new)
        return s, o_n

    xs = tuple(jnp.moveaxis(t, 2, 0) for t in (u, w, qk, q_dec, k_tail, g_last))
    s_fin, o = lax.scan(step, s0, xs)
    return s_fin, jnp.moveaxis(o, 0, 2).reshape(b, h, t_len, dv)


def dn_prepare(z_qkv, z_beta, z_a, conv_w, a_log, dt_bias, use_rope):
    qkv = jax.nn.silu(centred_dwconv(z_qkv, conv_w)).astype(jnp.float32)
    q, k, v = jnp.split(qkv, 3, axis=-1)
    q = l2norm(to_heads(q, DN_HEADS))
    k = l2norm(to_heads(k, DN_HEADS))
    v = to_heads(v, DN_HEADS)
    if use_rope:
        q = axial_rope(q, q.shape[2])
        k = axial_rope(k, k.shape[2])
    b, t_len, _ = z_beta.shape
    beta = jax.nn.sigmoid(z_beta.astype(jnp.float32)).reshape(b, t_len, 2, DN_HEADS).transpose(2, 0, 3, 1)
    a = z_a.astype(jnp.float32).reshape(b, t_len, 2, DN_HEADS).transpose(2, 0, 3, 1)
    g = -jnp.exp(a_log.astype(jnp.float32))[:, None, :, None] * jax.nn.softplus(
        a + dt_bias.astype(jnp.float32)[:, None, :, None])
    return q, k, v, g, beta


def dn_bidirectional(ctx_in, lat_in):
    qc, kc, vc, gc, bc = ctx_in
    ql, kl, vl, gl, bl = lat_in
    b, h, _, dk = kc.shape
    s0 = jnp.zeros((b, h, dk, vc.shape[-1]), jnp.float32)
    flip = lambda t: jnp.flip(t, axis=2)
    s_cf, o_cf = gated_delta_chunked(qc, kc, vc, gc[0], bc[0], s0)
    _, o_lf = gated_delta_chunked(ql, kl, vl, gl[0], bl[0], s_cf)
    s_cb, o_cb = gated_delta_chunked(flip(qc), flip(kc), flip(vc), flip(gc[1]), flip(bc[1]), s0)
    _, o_lb = gated_delta_chunked(flip(ql), flip(kl), flip(vl), flip(gl[1]), flip(bl[1]), s_cb)
    return o_cf + flip(o_cb), o_lf + flip(o_lb)


def dn_output(o, z_g, norm_w):
    b, h, t_len, dv = o.shape
    o = rmsnorm(o.transpose(0, 2, 1, 3), norm_w) * jax.nn.silu(z_g.astype(jnp.float32).reshape(b, t_len, h, dv))
    return o.reshape(b, t_len, h * dv).astype(z_g.dtype)


def merge_branches(o_na, o_dn, ga, gb, w_br_a, w_br_b, w_out):
    y = jax.nn.sigmoid(ga) * (o_na @ w_br_a) + jax.nn.sigmoid(gb) * (o_dn @ w_br_b)
    return y @ w_out


def mixer_sublayer(h_lat, h_ctx, w_in, na_rpb, dn_conv_w, dn_a_log, dn_dt_bias, dn_norm_w,
                   w_br_a, w_br_b, w_out, need_ctx_out):
    rows = h_lat.shape[1] // GRID_W
    naq_l, nak_l, nav_l, dqkv_l, dg_l, db_l, da_l, ga_l, gb_l = jnp.split(h_lat @ w_in, IN_OFFSETS, axis=-1)
    naq_c, nak_c, nav_c, dqkv_c, dg_c, db_c, da_c, ga_c, gb_c = jnp.split(h_ctx @ w_in, IN_OFFSETS, axis=-1)
    k_ctx = to_heads(nak_c, NA_HEADS)
    v_ctx = to_heads(nav_c, NA_HEADS)
    o_na_l = neighborhood_attention(to_heads(naq_l, NA_HEADS), to_heads(nak_l, NA_HEADS),
                                    to_heads(nav_l, NA_HEADS), k_ctx, v_ctx, na_rpb, rows)
    dn_c = dn_prepare(dqkv_c, db_c, da_c, dn_conv_w, dn_a_log, dn_dt_bias, False)
    dn_l = dn_prepare(dqkv_l, db_l, da_l, dn_conv_w, dn_a_log, dn_dt_bias, True)
    o_dn_c, o_dn_l = dn_bidirectional(dn_c, dn_l)
    y_lat = merge_branches(o_na_l, dn_output(o_dn_l, dg_l, dn_norm_w), ga_l, gb_l, w_br_a, w_br_b, w_out)
    y_ctx = None
    if need_ctx_out:
        o_na_c = context_attention(to_heads(naq_c, NA_HEADS), k_ctx, v_ctx)
        y_ctx = merge_branches(o_na_c, dn_output(o_dn_c, dg_c, dn_norm_w), ga_c, gb_c, w_br_a, w_br_b, w_out)
    return y_lat, y_ctx


def moe_ffn(h, w_router, b_router, w1, b1, w2, b2):
    b, t_len, d = h.shape
    xf = h.reshape(-1, d)
    n_tok = xf.shape[0]
    logits = (xf @ w_router + b_router).astype(jnp.float32)
    top_val, top_idx = lax.top_k(logits, TOP_K)
    gates = jax.nn.softmax(top_val, axis=-1)
    n_asg = n_tok * TOP_K
    e_flat = top_idx.reshape(-1)
    tok_flat = jnp.repeat(jnp.arange(n_tok, dtype=jnp.int32), TOP_K)
    order = jnp.argsort(e_flat, stable=True)
    e_sorted, tok_sorted, g_sorted = e_flat[order], tok_flat[order], gates.reshape(-1)[order]
    counts = jnp.zeros((N_EXPERTS,), jnp.int32).at[e_flat].add(1)
    starts = jnp.cumsum(counts) - counts
    padded = (counts + MOE_BLOCK - 1) // MOE_BLOCK * MOE_BLOCK
    pad_ends = jnp.cumsum(padded)
    pad_starts = pad_ends - padded
    dest = pad_starts[e_sorted] + (jnp.arange(n_asg, dtype=jnp.int32) - starts[e_sorted])
    m_pad = (n_asg + N_EXPERTS * (MOE_BLOCK - 1) + MOE_BLOCK - 1) // MOE_BLOCK * MOE_BLOCK
    n_blk = m_pad // MOE_BLOCK
    tok_pad = jnp.full((m_pad,), n_tok, jnp.int32).at[dest].set(tok_sorted)
    g_pad = jnp.zeros((m_pad,), jnp.float32).at[dest].set(g_sorted)
    blk_expert = jnp.minimum(jnp.searchsorted(pad_ends, jnp.arange(n_blk, dtype=jnp.int32) * MOE_BLOCK,
                                              side='right'), N_EXPERTS - 1)
    x_pad = jnp.concatenate([xf, jnp.zeros((1, d), xf.dtype)], axis=0)[tok_pad].reshape(n_blk, MOE_BLOCK, d)

    def expert_block(args):
        xb, e = args
        hb = xb @ w1[e] + b1[e]
        gate, up = hb[:, :D_EXPERT], hb[:, D_EXPERT:]
        gate = jnp.minimum(gate, SWIGLU_LIMIT)
        up = jnp.clip(up, -SWIGLU_LIMIT, SWIGLU_LIMIT)
        act = (up + 1.0) * gate * jax.nn.sigmoid(SWIGLU_ALPHA * gate)
        return act @ w2[e] + b2[e]

    y_pad = lax.map(expert_block, (x_pad, blk_expert)).reshape(m_pad, d)
    y = jax.ops.segment_sum(y_pad.astype(jnp.float32) * g_pad[:, None], tok_pad, num_segments=n_tok + 1)[:n_tok]
    return y.reshape(b, t_len, d).astype(h.dtype)


def setup_inputs(seed: int = 0) -> dict:
    key = jax.random.key(seed)
    ks = jax.random.split(key, 24)
    f32 = jnp.float32
    L, D, E, F = DEPTH, D_MODEL, N_EXPERTS, D_EXPERT

    def nrm(k, shape, scale):
        return jax.random.normal(k, shape, f32) * scale

    dt = jnp.exp(jax.random.uniform(ks[10], (L, 2, DN_HEADS), f32, math.log(1e-3), math.log(1e-1)))
    return {
        'x': nrm(ks[0], (BATCH, SEQ, D), 1.0),
        'c': nrm(ks[1], (BATCH, D), 1.0),
        'ctx': nrm(ks[2], (BATCH, CTX_LEN, D), 1.0),
        'c_ctx': nrm(ks[3], (D,), 1.0),
        'w_mod': nrm(ks[4], (L, D, 6 * D), 0.5 * D ** -0.5),
        'b_mod': nrm(ks[5], (L, 6 * D), 0.01),
        'norm1_w': 1.0 + nrm(ks[6], (L, D), 0.01),
        'w_in': nrm(ks[7], (L, D, D_IN), D ** -0.5),
        'na_rpb': nrm(ks[8], (L, NA_HEADS, 2 * NA_KH - 1, 2 * NA_KW - 1), 0.1),
        'dn_conv_w': nrm(ks[9], (L, DN_CONV, 3 * DN_WIDTH), DN_CONV ** -0.5),
        'dn_a_log': jnp.log(jax.random.uniform(ks[11], (L, 2, DN_HEADS), f32, 1.0, 16.0)),
        'dn_dt_bias': dt + jnp.log(-jnp.expm1(-dt)),
        'dn_norm_w': 1.0 + nrm(ks[12], (L, DN_HEAD_DIM), 0.01),
        'w_br_a': nrm(ks[13], (L, NA_WIDTH, D), NA_WIDTH ** -0.5),
        'w_br_b': nrm(ks[14], (L, DN_WIDTH, D), DN_WIDTH ** -0.5),
        'w_out': nrm(ks[15], (L, D, D), D ** -0.5),
        'norm2_w': 1.0 + nrm(ks[16], (L, D), 0.01),
        'w_router': nrm(ks[17], (L, D, E), D ** -0.5),
        'b_router': nrm(ks[18], (L, E), 0.01),
        'w1': nrm(ks[19], (L, E, D, 2 * F), D ** -0.5),
        'b1': nrm(ks[20], (L, E, 2 * F), 0.01),
        'w2': nrm(ks[21], (L, E, F, D), F ** -0.5),
        'b2': nrm(ks[22], (L, E, D), 0.01),
        'final_norm_w': 1.0 + nrm(ks[23], (D,), 0.01),
    }


def reference(x, c, ctx, c_ctx, w_mod, b_mod, norm1_w, w_in, na_rpb, dn_conv_w, dn_a_log, dn_dt_bias,
              dn_norm_w, w_br_a, w_br_b, w_out, norm2_w, w_router, b_router, w1, b1, w2, b2, final_norm_w):
    xl, xc = x, ctx
    for layer in range(DEPTH):
        last = layer == DEPTH - 1
        mod_l = (jax.nn.silu(c) @ w_mod[layer] + b_mod[layer])[:, None, :]
        mod_c = (jax.nn.silu(c_ctx) @ w_mod[layer] + b_mod[layer])[None, None, :]
        sh1_l, sc1_l, g1_l, sh2_l, sc2_l, g2_l = jnp.split(mod_l, 6, axis=-1)
        sh1_c, sc1_c, g1_c, sh2_c, sc2_c, g2_c = jnp.split(mod_c, 6, axis=-1)
        hl = modulate(rmsnorm(xl, norm1_w[layer]), sh1_l, sc1_l)
        hc = modulate(rmsnorm(xc, norm1_w[layer]), sh1_c, sc1_c)
        yl, yc = mixer_sublayer(hl, hc, w_in[layer], na_rpb[layer], dn_conv_w[layer], dn_a_log[layer],
                                dn_dt_bias[layer], dn_norm_w[layer], w_br_a[layer], w_br_b[layer],
                                w_out[layer], not last)
        xl = xl + g1_l * yl
        xl = xl + g2_l * moe_ffn(modulate(rmsnorm(xl, norm2_w[layer]), sh2_l, sc2_l), w_router[layer],
                                 b_router[layer], w1[layer], b1[layer], w2[layer], b2[layer])
        if not last:
            xc = xc + g1_c * yc
            xc = xc + g2_c * moe_ffn(modulate(rmsnorm(xc, norm2_w[layer]), sh2_c, sc2_c), w_router[layer],
                                     b_router[layer], w1[layer], b1[layer], w2[layer], b2[layer])
    return rmsnorm(xl, final_norm_w)
```

```cpp
#include <hip/hip_runtime.h>
#include <cstdio>
#include <cstdint>
namespace mk {
#define LAS __attribute__((address_space(3)))
#define GAS __attribute__((address_space(1)))
typedef unsigned short bf16;
typedef short bf16x8 __attribute__((ext_vector_type(8)));
typedef float f32x4 __attribute__((ext_vector_type(4)));
typedef float f32x2 __attribute__((ext_vector_type(2)));
typedef unsigned u32x4 __attribute__((ext_vector_type(4)));
typedef unsigned u32x2 __attribute__((ext_vector_type(2)));

constexpr int D = 1024, NB = 8, T = 2048, LC = 256, NT = NB * T, NC = NB * LC, NR = NT + NC, H = 8;
constexpr int NPROJ = 5632;
constexpr int P_NAQ = 0, P_NAK = 512, P_NAV = 1024, P_DQ = 1536, P_DK = 2048, P_DV = 2560, P_DG = 3072, P_GA = 3584, P_GB = 4608;
constexpr int E = 32, FF = 1024, DIN = 5664;
constexpr float EPS = 1e-6f;
constexpr int NWAVES = 8, NTHR = 512;
constexpr int MAXMT = 288;

constexpr size_t MiB = 1u << 20;
constexpr size_t WS_CTL = 0, CTL_BYTES = 40960;
constexpr size_t WS_MOD = 1 * MiB, WS_ROPE = 2 * MiB, WS_W32 = 3 * MiB, WS_BETA = 4 * MiB, WS_G = 6 * MiB;
constexpr size_t WS_TOKL = 8 * MiB, WS_GATEL = 10 * MiB, WS_ASG = 12 * MiB;
constexpr size_t WS_WIN = 16 * MiB, WS_WBR = 28 * MiB, WS_WOUT = 30 * MiB, WS_W1 = 32 * MiB, WS_W2 = 160 * MiB;
constexpr size_t WS_H = 224 * MiB, WS_PROJ = 260 * MiB, WS_ACT = 260 * MiB, WS_DNOP = 458 * MiB, WS_Y2 = 458 * MiB;
constexpr size_t WS_OF = 896 * MiB, WS_OB = 928 * MiB, WS_OCAT = 960 * MiB, WS_Y1 = 992 * MiB, WS_END = 1024 * MiB;
constexpr int CW_CNT = 64, CW_BAR = 4096;

__device__ __forceinline__ float siluf(float x) { return x / (1.f + __expf(-x)); }
__device__ __forceinline__ float sigmf(float x) { return 1.f / (1.f + __expf(-x)); }
__device__ __forceinline__ unsigned f2bf(float f) { unsigned u = __builtin_bit_cast(unsigned, f); return (u + 0x7fffu + ((u >> 16) & 1u)) >> 16; }
__device__ __forceinline__ float bf2f(unsigned b) { return __builtin_bit_cast(float, b << 16); }

__device__ __forceinline__ unsigned pk2(float lo, float hi);
typedef __bf16 bf16x2_t __attribute__((ext_vector_type(2)));
__device__ __forceinline__ unsigned cvt_pk_bf16(float lo, float hi) { const f32x2 v = {lo, hi}; const bf16x2_t b = __builtin_convertvector(v, bf16x2_t); return __builtin_bit_cast(unsigned, b); }
__device__ __forceinline__ unsigned pk2(float lo, float hi) { return cvt_pk_bf16(lo, hi); }
#define LDS_WAIT() asm volatile("s_waitcnt lgkmcnt(0)" ::: "memory")
#define VM_WAIT() asm volatile("s_waitcnt vmcnt(0)" ::: "memory")

#define XB_TMO      128
#define XB_XCNT(j)  (256  + 64 * (j))
#define XB_XSUB(j)  (1280 + 64 * (j))
#define XB_XGEN(j)  (2304 + 64 * (j))
#define XB_TOP      3328
#define XB_TOPGEN   3392
#define XCD_BAR_WORDS 3456
#define XB_SPIN_CAP (1u << 18)
__device__ __forceinline__ unsigned xb_ld(unsigned* p)              { return __hip_atomic_load(p, __ATOMIC_RELAXED, __HIP_MEMORY_SCOPE_AGENT); }
__device__ __forceinline__ unsigned xb_add(unsigned* p, unsigned v) { return __hip_atomic_fetch_add(p, v, __ATOMIC_RELAXED, __HIP_MEMORY_SCOPE_AGENT); }
__device__ __forceinline__ unsigned xb_xcc_id() { return (unsigned)__builtin_amdgcn_s_getreg((3 << 11) | 20) & 0xFu; }
#define XB_SPIN(cond, bar) do { unsigned _sp = 0; while (cond) { __builtin_amdgcn_s_sleep(1); \
    if ((++_sp & 255u) == 0u) { if (xb_ld(&(bar)[XB_TMO])) break; if (_sp > XB_SPIN_CAP) { atomicAdd(&(bar)[XB_TMO], 1u); break; } } } } while (0)
struct XcdBarrier { unsigned* bar; unsigned x; volatile LAS unsigned* st; };
__device__ __forceinline__ XcdBarrier xcd_barrier_post(unsigned* bar, volatile LAS unsigned* st) {
    XcdBarrier b; b.bar = bar; b.x = xb_xcc_id(); b.st = st;
    if (threadIdx.x == 0) (void)xb_add(&bar[XB_XCNT(b.x)], 1u);
    return b;
}
__device__ __forceinline__ void xcd_barrier_complete(unsigned* bar, unsigned x, unsigned& nloc, unsigned& nx) {
    const unsigned G = gridDim.x * gridDim.y * gridDim.z;
    unsigned sum, cnt, mine, sp = 0u;
    for (;;) {
        sum = 0u; cnt = 0u; mine = 0u;
#pragma unroll
        for (unsigned j = 0; j < 16; ++j) { const unsigned c = xb_ld(&bar[XB_XCNT(j)]); sum += c; cnt += (c > 0u) ? 1u : 0u; mine = (j == x) ? c : mine; }
        if (sum == G) break;
        __builtin_amdgcn_s_sleep(1);
        if ((++sp & 255u) == 0u) { if (xb_ld(&bar[XB_TMO])) break; if (sp > XB_SPIN_CAP) { atomicAdd(&bar[XB_TMO], 1u); break; } }
    }
    nloc = mine > 0u ? mine : 1u; nx = cnt > 0u ? cnt : 1u;
}
__device__ __forceinline__ void xcd_barrier(const XcdBarrier& b, int wave) {
    asm volatile("s_waitcnt vmcnt(0)" ::: "memory");
    __syncthreads();
    int ln_; asm volatile("v_mbcnt_lo_u32_b32 %0, -1, 0\n\tv_mbcnt_hi_u32_b32 %0, -1, %0" : "=v"(ln_));
    if (wave == 0 && ln_ == 0) {
        unsigned* bar = b.bar;
        __builtin_amdgcn_s_waitcnt(0);
        unsigned nloc = b.st[0], nx = b.st[1];
        if (nloc == 0u) { xcd_barrier_complete(bar, b.x, nloc, nx); b.st[0] = nloc; b.st[1] = nx; }
        const unsigned old = xb_add(&bar[XB_XSUB(b.x)], 1u);
        const unsigned gen = old / nloc;
        if (old + 1u == (gen + 1u) * nloc) {
            __builtin_amdgcn_fence(__ATOMIC_RELEASE, "agent");
            asm volatile("s_waitcnt vmcnt(0)" ::: "memory");
            const unsigned og = xb_add(&bar[XB_TOP], 1u);
            const unsigned tg = og / nx;
            if (og + 1u == (tg + 1u) * nx) xb_add(&bar[XB_TOPGEN], 1u);
            else XB_SPIN(xb_ld(&bar[XB_TOPGEN]) == tg, bar);
            __builtin_amdgcn_fence(__ATOMIC_ACQUIRE, "agent");
            xb_add(&bar[XB_XGEN(b.x)], 1u);
            asm volatile("s_waitcnt vmcnt(0)" ::: "memory");
        } else {
            XB_SPIN(xb_ld(&bar[XB_XGEN(b.x)]) == gen, bar);
            __builtin_amdgcn_fence(__ATOMIC_ACQUIRE, "agent");
            asm volatile("s_waitcnt vmcnt(0)" ::: "memory");
        }
    }
    __syncthreads();
}

constexpr int BM = 256, BK = 64, HALF = 128, HTB = HALF * BK * 2, STAGE_BYTES = 8 * HTB;
__host__ __device__ __forceinline__ int lds_byte(int r, int c) { const int st = (r >> 4) * 2 + (c >> 5), rr = r & 15, cc = c & 31, ob = rr * 64 + cc * 2; return st * 1024 + (ob ^ (((ob >> 9) & 1) << 5)); }
__host__ __device__ __forceinline__ void stage_rc(int b, int& R, int& C) { const int st = b / 1024, sb = b % 1024, swz = sb ^ (((sb >> 9) & 1) << 5); R = (st >> 1) * 16 + swz / 64; C = (st & 1) * 32 + (swz % 64) / 2; }
__host__ __device__ __forceinline__ int perm32(int rho) { const int n = rho >> 4, i = rho & 15; return 8 * (i >> 2) + 4 * n + (i & 3); }
typedef int i32x8 __attribute__((ext_vector_type(8)));
typedef int i32x4 __attribute__((ext_vector_type(4)));
__device__ __forceinline__ f32x4 mfma_f8(bf16x8 a0, bf16x8 a1, bf16x8 b0, bf16x8 b1, f32x4 c) {
    const i32x4 a0i = __builtin_bit_cast(i32x4, a0), a1i = __builtin_bit_cast(i32x4, a1), b0i = __builtin_bit_cast(i32x4, b0), b1i = __builtin_bit_cast(i32x4, b1);
    const i32x8 A = __builtin_shufflevector(a0i, a1i, 0, 1, 2, 3, 4, 5, 6, 7), B = __builtin_shufflevector(b0i, b1i, 0, 1, 2, 3, 4, 5, 6, 7);
    return __builtin_amdgcn_mfma_scale_f32_16x16x128_f8f6f4(A, B, c, 0, 0, 0, 0x7f7f7f7f, 0, 0x7f7f7f7f);
}
__device__ __forceinline__ unsigned pk4_fp8(float a, float b, float c, float d) {
    a = fminf(fmaxf(a, -448.f), 448.f); b = fminf(fmaxf(b, -448.f), 448.f); c = fminf(fmaxf(c, -448.f), 448.f); d = fminf(fmaxf(d, -448.f), 448.f);
    int p = __builtin_amdgcn_cvt_pk_fp8_f32(a, b, 0, false); p = __builtin_amdgcn_cvt_pk_fp8_f32(c, d, p, true); return (unsigned)p;
}
struct Unit { int pm, pn, e, rb; };

template <class P>
__device__ __forceinline__ void gemm_phase(LAS unsigned char* lds, const P& S, int wave_id) {
    const int wid = wave_id, wr = wid >> 2, wc = wid & 3;
#define PG8_LANE() ({ int _ln; asm volatile("v_mbcnt_lo_u32_b32 %0, -1, 0\n\tv_mbcnt_hi_u32_b32 %0, -1, %0" : "=v"(_ln)); _ln; })
#define tid (wid * 64 + PG8_LANE())
    constexpr int RB = P::ROWB, nt = RB / (BK * 2);
    unsigned voffB;
    { int R, C; stage_rc(tid * 16, R, C); const int Rb = P::PERM ? ((R & ~31) + perm32(R & 31)) : R; voffB = (unsigned)(Rb * RB + C * 2); }
#define PG8_STAGE1(bufoff, gbase, voff1) do { _Pragma("unroll") for (int _i = 0; _i < 2; ++_i) { unsigned _vo = (voff1); asm volatile("" : "+v"(_vo)); \
        __builtin_amdgcn_global_load_lds((const unsigned*)((const char*)(gbase) + (size_t)_i * 64 * RB + _vo), (LAS unsigned*)(lds + (bufoff) + ldsw + _i * 8192), 16, 0, 0); } } while (0)
#define PG8_AOFFS(unit, dst) do { const int _t = tid; int sR[2], sC[2]; _Pragma("unroll") for (int _i = 0; _i < 2; ++_i) stage_rc(_t * 16 + _i * 8192, sR[_i], sC[_i]); S.a_offs(unit, sR, sC, dst); } while (0)
    const size_t kstep = (size_t)(BK * 2);
    const size_t hstep = (size_t)HALF * RB;
    const unsigned ldsw = (unsigned)wid * 1024u;
    int aoff, boff; { const int _l = PG8_LANE(), fr = _l & 15, fq = _l >> 4; aoff = lds_byte(wr * 64 + fr, fq * 8); boff = lds_byte(wc * 32 + fr, fq * 8); }
#define PG8_SA(b, h) (((b) * 2 + (h)) * HTB)
#define PG8_SB(b, h) ((4 + (b) * 2 + (h)) * HTB)
#define PG8_STAGE(bufoff, gbase, voff) do { _Pragma("unroll") for (int _i = 0; _i < 2; ++_i) { unsigned _vo = (voff)[_i]; asm volatile("" : "+v"(_vo)); \
        __builtin_amdgcn_global_load_lds((const unsigned*)((const char*)(gbase) + _vo), (LAS unsigned*)(lds + (bufoff) + ldsw + _i * 8192), 16, 0, 0); } } while (0)
#define PG8_LDA(dst, b, h) do { _Pragma("unroll") for (int m = 0; m < 4; ++m) _Pragma("unroll") for (int k = 0; k < 2; ++k) dst[m][k] = *(const LAS bf16x8*)(lds + PG8_SA(b, h) + aoff + m * 2048 + k * 1024); } while (0)
#define PG8_LDB(dst, b, h) do { _Pragma("unroll") for (int n = 0; n < 2; ++n) _Pragma("unroll") for (int k = 0; k < 2; ++k) dst[n][k] = *(const LAS bf16x8*)(lds + PG8_SB(b, h) + boff + n * 2048 + k * 1024); } while (0)
#define PG8_MMA(ai, bj, At, Bt) do { __builtin_amdgcn_s_setprio(1); _Pragma("unroll") for (int m = 0; m < 4; ++m) _Pragma("unroll") for (int n = 0; n < 2; ++n) { \
        if constexpr (P::F8) acc[ai][bj][m][n] = mfma_f8(Bt[n][0], Bt[n][1], At[m][0], At[m][1], acc[ai][bj][m][n]); \
        else { _Pragma("unroll") for (int k = 0; k < 2; ++k) acc[ai][bj][m][n] = __builtin_amdgcn_mfma_f32_16x16x32_bf16(Bt[n][k], At[m][k], acc[ai][bj][m][n], 0, 0, 0); } } __builtin_amdgcn_s_setprio(0); } while (0)
#define PG8_WAIT_V(n) asm volatile("s_waitcnt vmcnt(" #n ")" ::: "memory")
#define PG8_WAIT_L(n) asm volatile("s_waitcnt lgkmcnt(" #n ")" ::: "memory")
#define PG8_BAR __builtin_amdgcn_s_barrier()
#define PG8_SCHED __builtin_amdgcn_sched_barrier(0)
    Unit cur, nxt; int ui = 0;
    if (!S.next(0, cur)) return;
    f32x4 acc[2][2][4][2];
#pragma unroll
    for (int a = 0; a < 2; ++a)
#pragma unroll
        for (int b = 0; b < 2; ++b)
#pragma unroll
            for (int m = 0; m < 4; ++m)
#pragma unroll
                for (int n = 0; n < 2; ++n) acc[a][b][m][n] = (f32x4){0.f, 0.f, 0.f, 0.f};
    bf16x8 At[4][2], B0[2][2], B1[2][2];
    unsigned vA[2][2];
#define stash ((LAS unsigned*)(lds + STAGE_BYTES) + tid * 4)
    if constexpr (P::DENSE) { int R, C; stage_rc(tid * 16, R, C); vA[0][0] = (unsigned)(R * RB + C * 2); vA[0][1] = 0u; vA[1][0] = 0u; vA[1][1] = 0u; }
    else PG8_AOFFS(cur, vA);
#define PG8_STAGE_A(bufoff, base, h) do { if constexpr (P::DENSE) PG8_STAGE1(bufoff, (base) + (h) * hstep, vA[0][0]); else PG8_STAGE(bufoff, base, vA[h]); } while (0)
#define PG8_STAGE_AN(bufoff, base, h) do { if constexpr (P::DENSE) PG8_STAGE1(bufoff, (base) + (h) * hstep, vA[0][0]); else { unsigned _w[2]; \
        { const unsigned _s0 = stash[2 * (h)], _s1 = stash[2 * (h) + 1]; _w[0] = last ? _s0 : vA[h][0]; _w[1] = last ? _s1 : vA[h][1]; } PG8_STAGE(bufoff, base, _w); } } while (0)
    const char* cA = S.a_base(cur); const char* cB = S.b_base(cur);
    PG8_STAGE1(PG8_SB(0, 0), cB, voffB); PG8_STAGE1(PG8_SB(0, 1), cB + hstep, voffB); PG8_STAGE_A(PG8_SA(0, 0), cA, 0); PG8_STAGE_A(PG8_SA(0, 1), cA, 1);
    if (wr == 1) PG8_BAR;
    PG8_WAIT_V(2); PG8_BAR;
    PG8_STAGE1(PG8_SB(1, 0), cB + kstep, voffB); PG8_STAGE_A(PG8_SA(1, 0), cA + kstep, 0); PG8_STAGE1(PG8_SB(1, 1), cB + hstep + kstep, voffB);
    PG8_WAIT_V(6); PG8_BAR;
    for (;;) {
        const bool has_next = S.next(ui + 1, nxt);
        const char* nA = cA; const char* nB = cB;
        if (has_next) { nA = S.a_base(nxt); nB = S.b_base(nxt); }
        if constexpr (!P::DENSE) { unsigned nv[2][2];
#pragma unroll
            for (int h = 0; h < 2; ++h)
#pragma unroll
                for (int i = 0; i < 2; ++i) nv[h][i] = vA[h][i];
            if (has_next) PG8_AOFFS(nxt, nv);
            stash[0] = nv[0][0]; stash[1] = nv[0][1]; stash[2] = nv[1][0]; stash[3] = nv[1][1]; }
#pragma unroll 1
        for (int t = 0; t < nt; t += 2) {
            const bool last = (t == nt - 2);
            if constexpr (P::HOOK) { if (t == nt / 2) { const int _l = PG8_LANE(); S.hook(acc, cur, wr, wc, _l & 15, _l >> 4); } }
            const char* a1 = cA + (size_t)(t + 1) * kstep;
            const char* a2 = last ? nA : cA + (size_t)(t + 2) * kstep; const char* b2 = last ? nB : cB + (size_t)(t + 2) * kstep;
            const char* a3 = a2 + kstep; const char* b3 = b2 + kstep;
            PG8_LDB(B0, 0, 0); PG8_LDB(B1, 0, 1); PG8_SCHED; PG8_LDA(At, 0, 0); PG8_STAGE_A(PG8_SA(1, 1), a1, 1);
            PG8_WAIT_V(8); PG8_WAIT_L(0); PG8_BAR; PG8_MMA(0, 0, At, B0); PG8_MMA(0, 1, At, B1); PG8_BAR; PG8_SCHED;
            PG8_LDA(At, 0, 1); PG8_STAGE1(PG8_SB(0, 0), b2, voffB); PG8_STAGE1(PG8_SB(0, 1), b2 + hstep, voffB); PG8_STAGE_AN(PG8_SA(0, 0), a2, 0);
            PG8_WAIT_V(8); PG8_WAIT_L(0); PG8_BAR; PG8_MMA(1, 0, At, B0); PG8_MMA(1, 1, At, B1); PG8_BAR; PG8_SCHED;
            PG8_LDB(B0, 1, 0); PG8_LDB(B1, 1, 1); PG8_SCHED; PG8_LDA(At, 1, 0); PG8_STAGE_AN(PG8_SA(0, 1), a2, 1);
            PG8_WAIT_V(8); PG8_WAIT_L(0); PG8_BAR; PG8_MMA(0, 0, At, B0); PG8_MMA(0, 1, At, B1); PG8_BAR; PG8_SCHED;
            PG8_LDA(At, 1, 1); PG8_STAGE1(PG8_SB(1, 0), b3, voffB); PG8_STAGE1(PG8_SB(1, 1), b3 + hstep, voffB); PG8_STAGE_AN(PG8_SA(1, 0), a3, 0);
            PG8_WAIT_V(8); PG8_WAIT_L(0); PG8_BAR; PG8_MMA(1, 0, At, B0); PG8_MMA(1, 1, At, B1); PG8_BAR; PG8_SCHED;
        }
        if (wr == 0) PG8_BAR;
        { const int _l = PG8_LANE(); S.epi(acc, cur, wr, wc, _l & 15, _l >> 4); }
        if (!has_next) break;
#pragma unroll
        for (int a = 0; a < 2; ++a)
#pragma unroll
            for (int b = 0; b < 2; ++b)
#pragma unroll
                for (int m = 0; m < 4; ++m)
#pragma unroll
                    for (int n = 0; n < 2; ++n) acc[a][b][m][n] = (f32x4){0.f, 0.f, 0.f, 0.f};
        cur = nxt; cA = nA; cB = nB; ++ui;
        if constexpr (!P::DENSE) { vA[0][0] = stash[0]; vA[0][1] = stash[1]; vA[1][0] = stash[2]; vA[1][1] = stash[3]; }
        if (wr == 1) PG8_BAR;
    }
    PG8_WAIT_V(0);
    PG8_BAR;
#undef PG8_AOFFS
#undef tid
#undef PG8_LANE
#undef stash
#undef PG8_STAGE_A
#undef PG8_STAGE1
#undef PG8_STAGE_AN
#undef PG8_SA
#undef PG8_SB
#undef PG8_STAGE
#undef PG8_LDA
#undef PG8_LDB
#undef PG8_MMA
#undef PG8_WAIT_V
#undef PG8_WAIT_L
#undef PG8_BAR
#undef PG8_SCHED
}
struct Args {
    const float* in[24]; float* out; unsigned char* ws;
    int ph_lo, ph_hi, p4mode, pad;
};
struct Frame {
    LAS unsigned char* lds; unsigned char* ws;
    int tid, lane, wave, vcu, G;
};
__device__ __forceinline__ void frame_refresh(Frame& F) { int l; asm volatile("v_mbcnt_lo_u32_b32 %0, -1, 0\n\tv_mbcnt_hi_u32_b32 %0, -1, %0" : "=v"(l)); F.lane = l; F.tid = F.wave * 64 + l; }
constexpr int RING_BYTES = 131072;
constexpr int MISC_OFF = 147456 - 4096;
constexpr int LDS_BYTES = 147456;

__device__ __forceinline__ float wave_sum(float v) {
#pragma unroll
    for (int o = 1; o < 64; o <<= 1) v += __shfl_xor(v, o);
    return v;
}

__device__ __forceinline__ void p0_transpose_item_f8(const float* src, int N, unsigned char* dst, int dstStride, LAS float* scr, int lane) {
#pragma unroll 8
    for (int i = 0; i < 32; ++i) { const int kk = 2 * i + (lane >> 5); scr[kk * 33 + (lane & 31)] = src[(size_t)kk * N + (lane & 31)]; }
    LDS_WAIT(); asm volatile("" ::: "memory");
    const int c = lane & 7;
#pragma unroll
    for (int j = 0; j < 4; ++j) { const int n = (lane >> 3) + 8 * j; const LAS float* s = scr + (8 * c) * 33 + n;
        float v[8];
#pragma unroll
        for (int q = 0; q < 8; ++q) v[q] = s[q * 33] * 256.f;
        u32x2 o; o.x = pk4_fp8(v[0], v[1], v[2], v[3]); o.y = pk4_fp8(v[4], v[5], v[6], v[7]);
        *(GAS u32x2*)(dst + (size_t)n * dstStride + 8 * c) = o; }
    LDS_WAIT(); asm volatile("" ::: "memory");
}
template <bool HILO>
__device__ __forceinline__ void p0_transpose_item(const float* src, int N, bf16* dst, int dstStride, size_t loOff, LAS float* scr, int lane) {
#pragma unroll 8
    for (int i = 0; i < 32; ++i) { const int kk = 2 * i + (lane >> 5); scr[kk * 33 + (lane & 31)] = src[(size_t)kk * N + (lane & 31)]; }
    LDS_WAIT(); asm volatile("" ::: "memory");
    const int c = lane & 7;
#pragma unroll
    for (int j = 0; j < 4; ++j) { const int n = (lane >> 3) + 8 * j; const LAS float* s = scr + (8 * c) * 33 + n;
        float v[8];
#pragma unroll
        for (int q = 0; q < 8; ++q) v[q] = s[q * 33];
        u32x4 o; o.x = pk2(v[0], v[1]); o.y = pk2(v[2], v[3]); o.z = pk2(v[4], v[5]); o.w = pk2(v[6], v[7]);
        *(GAS u32x4*)(dst + (size_t)n * dstStride + 8 * c) = o;
        if (HILO) { float r[8];
#pragma unroll
            for (int q = 0; q < 8; ++q) r[q] = v[q] - bf2f(f2bf(v[q]));
            u32x4 p; p.x = pk2(r[0], r[1]); p.y = pk2(r[2], r[3]); p.z = pk2(r[4], r[5]); p.w = pk2(r[6], r[7]);
            *(GAS u32x4*)(dst + loOff + (size_t)n * dstStride + 8 * c) = p; } }
    LDS_WAIT(); asm volatile("" ::: "memory");
}
__device__ __forceinline__ void p0_prologue(Frame& F, const Args& A) {
    const float* c = A.in[1]; const float* cctx = A.in[3]; const float* wmod = A.in[4]; const float* bmod = A.in[5];
    const float* win = A.in[7]; const float* wbra = A.in[13]; const float* wbrb = A.in[14]; const float* wout = A.in[15];
    const float* wrt = A.in[17]; const float* w1 = A.in[19]; const float* w2 = A.in[21];
    float* mod = (float*)(F.ws + WS_MOD); float* rope = (float*)(F.ws + WS_ROPE); bf16* w32 = (bf16*)(F.ws + WS_W32);
    bf16* WinT = (bf16*)(F.ws + WS_WIN); bf16* WbrT = (bf16*)(F.ws + WS_WBR); bf16* WoutT = (bf16*)(F.ws + WS_WOUT); bf16* W1T = (bf16*)(F.ws + WS_W1); bf16* W2T = (bf16*)(F.ws + WS_W2);
    for (int idx = blockIdx.x * NTHR + F.tid; idx < T * 32; idx += F.G * NTHR) {
        const int t = idx >> 5, i = idx & 31; const float pos = (i < 16) ? (float)(t >> 6) : (float)(t & 63);
        const float fr = powf(10000.f, -(float)(i & 15) / 16.f); float sn, cs; sincosf(pos * fr, &sn, &cs);
        rope[2 * idx] = cs; rope[2 * idx + 1] = sn; }
    {
        LAS float* sc = (LAS float*)(F.lds + 73728);
        LAS float* part = (LAS float*)(F.lds + 73728 + 36864);
        if ((int)blockIdx.x < 192) {
            for (int u = F.tid; u < 9 * D; u += NTHR) { const int r = u >> 10, k = u & 1023; const float v = r < 8 ? c[r * D + k] : cctx[k]; sc[u] = v / (1.f + expf(-v)); }
            __syncthreads();
            for (int item = blockIdx.x; item < 192; item += F.G) {
                const int n0 = item * 32, col = F.lane & 31, kp = F.lane >> 5;
                float a[9];
#pragma unroll
                for (int r = 0; r < 9; ++r) a[r] = 0.f;
#pragma unroll 4
                for (int i = 0; i < 64; ++i) { const int k = F.wave * 128 + 2 * i + kp; const float wv = wmod[(size_t)k * 6 * D + n0 + col];
#pragma unroll
                    for (int r = 0; r < 9; ++r) a[r] += sc[r * D + k] * wv; }
#pragma unroll
                for (int r = 0; r < 9; ++r) part[((F.wave * 2 + kp) * 9 + r) * 32 + col] = a[r];
                __syncthreads();
                if (F.tid < 288) { const int r = F.tid >> 5, cc = F.tid & 31; float s = 0.f;
#pragma unroll
                    for (int p = 0; p < 16; ++p) s += part[(p * 9 + r) * 32 + cc];
                    mod[r * 6 * D + n0 + cc] = s + bmod[n0 + cc]; }
                __syncthreads();
            }
        }
    }
    LAS float* scr = (LAS float*)(F.lds + F.wave * 9216);
    const int gw = F.vcu * NWAVES + F.wave, NGW = F.G * NWAVES;
    constexpr int I_IN = 16 * 177, I_BR = 8 * 32, I_OUT = 16 * 32, I_W1 = E * 16 * 64, I_W2 = E * 16 * 32, I_RT = 16;
    constexpr int NITEMS = I_IN + 2 * I_BR + I_OUT + I_W1 + I_W2 + I_RT;
    struct Desc { const float* src; unsigned char* dst; int N, dstStride, kind; bool valid; };
    auto describe = [&](int it) -> Desc { Desc d; d.valid = it < NITEMS; d.src = win; d.dst = (unsigned char*)WinT; d.N = DIN; d.dstStride = D * 2; d.kind = 0; if (!d.valid) return d;
        int r = it;
        if (r < I_IN) { const int kb = r / 177, nb = r % 177, n0 = nb * 32, k0 = kb * 64; d.src = win + (size_t)k0 * DIN + n0; d.N = DIN; d.dstStride = D * 2;
            if (n0 == 3584) { d.dst = (unsigned char*)(w32 + k0); d.kind = 1; } else { d.dst = (unsigned char*)(WinT + (size_t)(n0 < 3584 ? n0 : n0 - 32) * D + k0); d.kind = 0; } return d; } r -= I_IN;
        if (r < I_BR) { const int kb = r / 32, nb = r % 32; d.src = wbra + (size_t)(kb * 64) * D + nb * 32; d.N = D; d.dst = (unsigned char*)(WbrT + (size_t)(nb * 32) * D + kb * 64); d.dstStride = D * 2; return d; } r -= I_BR;
        if (r < I_BR) { const int kb = r / 32, nb = r % 32; d.src = wbrb + (size_t)(kb * 64) * D + nb * 32; d.N = D; d.dst = (unsigned char*)(WbrT + (size_t)(nb * 32) * D + 512 + kb * 64); d.dstStride = D * 2; return d; } r -= I_BR;
        if (r < I_OUT) { const int kb = r / 32, nb = r % 32; d.src = wout + (size_t)(kb * 64) * D + nb * 32; d.N = D; d.dst = (unsigned char*)(WoutT + (size_t)(nb * 32) * D + kb * 64); d.dstStride = D * 2; return d; } r -= I_OUT;
        if (r < I_W1) { const int e = r / 1024, q = r % 1024, kb = q / 64, nb = q % 64, n0 = nb * 32;
            const int drow = n0 < FF ? (n0 / 128) * 256 + (n0 % 128) : ((n0 - FF) / 128) * 256 + 128 + ((n0 - FF) % 128);
            d.src = w1 + ((size_t)e * D + kb * 64) * (2 * FF) + n0; d.N = 2 * FF; d.dst = (unsigned char*)W1T + ((size_t)e * 2 * FF + drow) * D + kb * 64; d.dstStride = D; d.kind = 2; return d; } r -= I_W1;
        if (r < I_W2) { const int e = r / 512, q = r % 512, kb = q / 32, nb = q % 32;
            d.src = w2 + ((size_t)e * FF + kb * 64) * D + nb * 32; d.N = D; d.dst = (unsigned char*)W2T + ((size_t)e * D + nb * 32) * FF + kb * 64; d.dstStride = FF; d.kind = 2; return d; } r -= I_W2;
        { const int kb = r; d.src = wrt + (size_t)(kb * 64) * E; d.N = E; d.dst = (unsigned char*)(w32 + 2 * 32 * D + kb * 64); d.dstStride = D * 2; d.kind = 1; return d; } };
    const int ln = F.lane;
#define P0_LOADS(reg, dsc) do { if ((dsc).valid) { _Pragma("unroll") for (int _i = 0; _i < 32; ++_i) reg[_i] = __builtin_nontemporal_load((dsc).src + (size_t)(2 * _i + (ln >> 5)) * (dsc).N + (ln & 31)); } } while (0)
#define P0_FINISH(reg, dsc) do { _Pragma("unroll") for (int _i = 0; _i < 32; ++_i) scr[(2 * _i + (ln >> 5)) * 33 + (ln & 31)] = reg[_i]; LDS_WAIT(); asm volatile("" ::: "memory"); } while (0)
#define P0_STORE(dsc) do { const int _c = ln & 7; _Pragma("unroll") for (int _j = 0; _j < 4; ++_j) { const int _n = (ln >> 3) + 8 * _j; const LAS float* _s = scr + (8 * _c) * 33 + _n; float _v[8]; \
            _Pragma("unroll") for (int _q = 0; _q < 8; ++_q) _v[_q] = _s[_q * 33]; \
            if ((dsc).kind == 2) { u32x2 _o; _o.x = pk4_fp8(_v[0] * 256.f, _v[1] * 256.f, _v[2] * 256.f, _v[3] * 256.f); _o.y = pk4_fp8(_v[4] * 256.f, _v[5] * 256.f, _v[6] * 256.f, _v[7] * 256.f); \
                *(GAS u32x2*)((dsc).dst + (size_t)_n * (dsc).dstStride + 8 * _c) = _o; } \
            else { u32x4 _o; _o.x = pk2(_v[0], _v[1]); _o.y = pk2(_v[2], _v[3]); _o.z = pk2(_v[4], _v[5]); _o.w = pk2(_v[6], _v[7]); *(GAS u32x4*)((dsc).dst + (size_t)_n * (dsc).dstStride + 16 * _c) = _o; \
                if ((dsc).kind == 1) { float _r[8]; _Pragma("unroll") for (int _q = 0; _q < 8; ++_q) _r[_q] = _v[_q] - bf2f(f2bf(_v[_q])); \
                    u32x4 _p; _p.x = pk2(_r[0], _r[1]); _p.y = pk2(_r[2], _r[3]); _p.z = pk2(_r[4], _r[5]); _p.w = pk2(_r[6], _r[7]); *(GAS u32x4*)((dsc).dst + (size_t)(32 + _n) * (dsc).dstStride + 16 * _c) = _p; } } } \
        LDS_WAIT(); asm volatile("" ::: "memory"); } while (0)
    float ldA[32], ldB[32];
#pragma unroll
    for (int i = 0; i < 32; ++i) { ldA[i] = 0.f; ldB[i] = 0.f; }
    Desc d0 = describe(gw), d1 = describe(gw + NGW);
    P0_LOADS(ldA, d0); P0_LOADS(ldB, d1);
    for (int it = gw; it < NITEMS; it += 2 * NGW) {
        P0_FINISH(ldA, d0); const Desc d2 = describe(it + 2 * NGW); P0_LOADS(ldA, d2); P0_STORE(d0);
        if (d1.valid) { P0_FINISH(ldB, d1); const Desc d3 = describe(it + 3 * NGW); P0_LOADS(ldB, d3); P0_STORE(d1); d1 = d3; }
        d0 = d2;
    }
#undef P0_LOADS
#undef P0_FINISH
#undef P0_STORE
}

constexpr int NS_W = 0, NS_WS = 1032, NS_A = 66048, NS_SH = 70144, NS_PART = 74240, NS_SS = 91136, NS_LC = 91648;
template <int MODE, int NK>
__device__ __forceinline__ void norm_skinny(Frame& F, const Args& A, int row_base, int nitems, bool stage) {
    constexpr int NG = 8 / NK, RPI = (NK == 2) ? 64 : 8, RS = (NK == 2) ? 64 : 16, KW = D / NK, NS = KW / 32;
    const int lane = F.lane, tid = F.tid, li = lane & 15, kq = lane >> 4;
    const bf16* whi = (const bf16*)(F.ws + WS_W32) + (MODE == 0 ? 0 : 2 * 32 * D);
    const float* mod = (const float*)(F.ws + WS_MOD);
    const float* nw = A.in[MODE == 0 ? 6 : 16];
    bf16* Hout = (bf16*)(F.ws + WS_H);
    LAS bf16* Wb = (LAS bf16*)(F.lds + NS_W); LAS float* av = (LAS float*)(F.lds + NS_A); LAS float* shv = (LAS float*)(F.lds + NS_SH);
    LAS float* part = (LAS float*)(F.lds + NS_PART); LAS float* ssp = (LAS float*)(F.lds + NS_SS); LAS unsigned* lcnt = (LAS unsigned*)(F.lds + NS_LC); LAS unsigned* lbase = lcnt + 32;
    if (stage && (int)blockIdx.x < nitems) {
#pragma unroll
        for (int i = 0; i < 8; ++i) { const int id = tid + NTHR * i, n = id >> 7, c = id & 127; *(LAS u32x4*)(Wb + n * NS_WS + c * 8) = *(const u32x4*)(whi + (size_t)n * D + c * 8); }
    }
    const int grp = F.wave % NG, kh = F.wave / NG;
    int cur_mr = -1;
    for (int item = blockIdx.x; item < nitems; item += F.G) {
        const int r0 = row_base + item * RPI; const int mr = (MODE == 0 && r0 >= NT) ? 8 : r0 / T;
        __syncthreads();
        if (mr != cur_mr) { cur_mr = mr; const float* sh = mod + mr * 6 * D + (MODE == 0 ? 0 : 3 * D); const float* sc = sh + D;
#pragma unroll
            for (int i = 0; i < 2; ++i) { const int k = tid + NTHR * i; av[k] = nw[k] * (1.f + sc[k]); shv[k] = sh[k]; } }
        if (MODE == 1 && tid < 32) lcnt[tid] = 0u;
        const int row = r0 + (NK == 2 ? 16 * grp + li : (li & 7));
        const float* xr;
        if (MODE == 0) xr = (row < NT) ? A.in[0] + (size_t)row * D : A.in[2] + (size_t)(row - NT) * D; else xr = A.out + (size_t)row * D;
        xr += KW * kh + 8 * kq;
        f32x4 xv[NS][2]; float ss = 0.f;
#pragma unroll
        for (int s = 0; s < NS; ++s) { if (MODE == 0) { xv[s][0] = __builtin_nontemporal_load((const f32x4*)(xr + 32 * s)); xv[s][1] = __builtin_nontemporal_load((const f32x4*)(xr + 32 * s + 4)); }
            else { xv[s][0] = __builtin_nontemporal_load((const f32x4*)(xr + 32 * s)); xv[s][1] = __builtin_nontemporal_load((const f32x4*)(xr + 32 * s + 4)); } }
#pragma unroll
        for (int s = 0; s < NS; ++s)
#pragma unroll
            for (int q = 0; q < 2; ++q) ss += (xv[s][q].x * xv[s][q].x + xv[s][q].y * xv[s][q].y) + (xv[s][q].z * xv[s][q].z + xv[s][q].w * xv[s][q].w);
        ss += __shfl_xor(ss, 16); ss += __shfl_xor(ss, 32);
        if (kq == 0) ssp[kh * RS + 16 * grp + li] = ss;
        __syncthreads();
        float sst = 0.f;
#pragma unroll
        for (int p = 0; p < NK; ++p) sst += ssp[p * RS + 16 * grp + li];
        const float rstd = rsqrtf(sst * (1.f / D) + EPS);
        f32x4 acc[2] = {(f32x4){0.f, 0.f, 0.f, 0.f}, (f32x4){0.f, 0.f, 0.f, 0.f}};
        bf16* hrow = Hout + (size_t)row * D + KW * kh + 8 * kq;
#pragma unroll
        for (int s = 0; s < NS; ++s) {
            const int k0 = KW * kh + 32 * s + 8 * kq;
            float hv[8];
#pragma unroll
            for (int q = 0; q < 2; ++q) { const f32x4 a4 = *(const LAS f32x4*)(av + k0 + 4 * q), s4 = *(const LAS f32x4*)(shv + k0 + 4 * q);
#pragma unroll
                for (int j = 0; j < 4; ++j) hv[4 * q + j] = xv[s][q][j] * rstd * a4[j] + s4[j]; }
            u32x4 hp, lp;
            hp.x = cvt_pk_bf16(hv[0], hv[1]); hp.y = cvt_pk_bf16(hv[2], hv[3]); hp.z = cvt_pk_bf16(hv[4], hv[5]); hp.w = cvt_pk_bf16(hv[6], hv[7]);
            lp.x = cvt_pk_bf16(hv[0] - bf2f(hp.x & 0xffffu), hv[1] - bf2f(hp.x >> 16)); lp.y = cvt_pk_bf16(hv[2] - bf2f(hp.y & 0xffffu), hv[3] - bf2f(hp.y >> 16));
            lp.z = cvt_pk_bf16(hv[4] - bf2f(hp.z & 0xffffu), hv[5] - bf2f(hp.z >> 16)); lp.w = cvt_pk_bf16(hv[6] - bf2f(hp.w & 0xffffu), hv[7] - bf2f(hp.w >> 16));
            if (MODE == 0) *(GAS u32x4*)(hrow + 32 * s) = hp;
            else { u32x2 q8; q8.x = pk4_fp8(hv[0] * 16.f, hv[1] * 16.f, hv[2] * 16.f, hv[3] * 16.f); q8.y = pk4_fp8(hv[4] * 16.f, hv[5] * 16.f, hv[6] * 16.f, hv[7] * 16.f);
                *(GAS u32x2*)((unsigned char*)Hout + (size_t)row * D + KW * kh + 8 * kq + 32 * s) = q8; }
            const bf16x8 Ahi = __builtin_bit_cast(bf16x8, hp), Alo = __builtin_bit_cast(bf16x8, lp);
#pragma unroll
            for (int n = 0; n < 2; ++n) { const bf16x8 Bf = *(const LAS bf16x8*)(Wb + (16 * n + li) * NS_WS + k0);
                acc[n] = __builtin_amdgcn_mfma_f32_16x16x32_bf16(Ahi, Bf, acc[n], 0, 0, 0);
                acc[n] = __builtin_amdgcn_mfma_f32_16x16x32_bf16(Alo, Bf, acc[n], 0, 0, 0); }
        }
#pragma unroll
        for (int n = 0; n < 2; ++n)
#pragma unroll
            for (int r = 0; r < 4; ++r) part[(kh * RS + 16 * grp + 4 * kq + r) * 33 + 16 * n + li] = acc[n][r];
        __syncthreads();
        if (MODE == 0) {
            float* beta = (float*)(F.ws + WS_BETA); float* gg = (float*)(F.ws + WS_G);
            const int rl = tid >> 3, j0 = (tid & 7) * 2;
#pragma unroll
            for (int jj = 0; jj < 2; ++jj) { const int j = j0 + jj; if (rl >= RPI) break; float zb = 0.f, za = 0.f;
#pragma unroll
                for (int p = 0; p < NK; ++p) { zb += part[(p * RS + rl) * 33 + j]; za += part[(p * RS + rl) * 33 + 16 + j]; }
                const float al = -expf(A.in[10][j]), db = A.in[11][j];
                beta[(size_t)(r0 + rl) * 16 + j] = 1.f / (1.f + expf(-zb));
                const float xx = za + db; const float sp = xx > 20.f ? xx : log1pf(expf(xx)); gg[(size_t)(r0 + rl) * 16 + j] = al * sp; }
        } else {
            unsigned* cnt = (unsigned*)(F.ws + WS_CTL) + CW_CNT; int* tokl = (int*)(F.ws + WS_TOKL); float* gatel = (float*)(F.ws + WS_GATEL); int* asg = (int*)(F.ws + WS_ASG);
            const float* brt = A.in[18];
            int li4[4]; float gv[4]; unsigned lp4[4];
            if (tid < 64) {
                const LAS float* p0 = part + tid * 33; const LAS float* p1 = part + (64 + tid) * 33;
                float lv[4]; unsigned used = 0u;
#pragma unroll
                for (int k = 0; k < 4; ++k) { float best = -3.0e38f; int bi = 0;
                    for (int e = 0; e < E; ++e) { const float v = p0[e] + p1[e] + brt[e]; if (!((used >> e) & 1u) && v > best) { best = v; bi = e; } }
                    used |= 1u << bi; lv[k] = best; li4[k] = bi; }
                float s = 0.f;
#pragma unroll
                for (int k = 0; k < 4; ++k) { gv[k] = expf(lv[k] - lv[0]); s += gv[k]; }
                const float inv = 1.f / s;
#pragma unroll
                for (int k = 0; k < 4; ++k) { gv[k] *= inv; lp4[k] = __hip_atomic_fetch_add(lcnt + li4[k], 1u, __ATOMIC_RELAXED, __HIP_MEMORY_SCOPE_WORKGROUP); }
            }
            __syncthreads();
            if (tid < 32) { const unsigned n = lcnt[tid]; lbase[tid] = n ? xb_add(&cnt[tid * 64], n) : 0u; }
            __syncthreads();
            if (tid < 64) { const int tok = r0 + tid;
#pragma unroll
                for (int k = 0; k < 4; ++k) { const int e = li4[k]; const unsigned pos = lbase[e] + lp4[k];
                    tokl[(size_t)e * NT + pos] = tok; gatel[(size_t)e * NT + pos] = gv[k]; asg[tok * 4 + k] = (e << 16) | (int)pos; } }
        }
    }
}

struct ProbProj {
    static constexpr int STAMP_ID = 2;
    static constexpr int K = D, ROWB = 2 * D; static constexpr bool PERM = true, HOOK = false, F8 = false, DENSE = true;
    const bf16* A; const bf16* Bt; bf16* O; int G, c;
    __device__ __forceinline__ bool next(int i, Unit& u) const {
        const int L = i * G + c; constexpr int NLAT = 64 * 22, NCTX = 8 * 8;
        if (L >= NLAT + NCTX) return false;
        if (L < NLAT) { u.pm = L / 22; u.pn = L % 22; }
        else { const int q = L - NLAT; const int j = q & 7; u.pm = 64 + (q >> 3); u.pn = (j < 4) ? 2 + j : 4 + j; }
        u.e = 0; u.rb = 0; return true;
    }
    __device__ __forceinline__ const char* a_base(const Unit& u) const { return (const char*)A + (size_t)u.pm * BM * K * 2; }
    __device__ __forceinline__ void a_offs(const Unit&, const int (&R)[2], const int (&C)[2], unsigned (&v)[2][2]) const {
#pragma unroll
        for (int h = 0; h < 2; ++h)
#pragma unroll
            for (int i = 0; i < 2; ++i) v[h][i] = (unsigned)((h * HALF + R[i]) * K + C[i]) * 2u; }
    __device__ __forceinline__ const char* b_base(const Unit& u) const { return (const char*)Bt + (size_t)u.pn * BM * K * 2; }
    __device__ __forceinline__ void hook(f32x4 (&)[2][2][4][2], const Unit&, int, int, int, int) const {}
    __device__ __forceinline__ void epi(const f32x4 (&acc)[2][2][4][2], const Unit& u, int wr, int wc, int fr, int fq) const {
        const int row0 = u.pm * BM + wr * 64 + fr, col0 = u.pn * BM + wc * 32 + 8 * fq;
#pragma unroll
        for (int ai = 0; ai < 2; ++ai)
#pragma unroll
            for (int m = 0; m < 4; ++m) { bf16* rowp = O + (size_t)(row0 + ai * HALF + m * 16) * NPROJ + col0;
#pragma unroll
                for (int bj = 0; bj < 2; ++bj) { const f32x4 v0 = acc[ai][bj][m][0], v1 = acc[ai][bj][m][1];
                    u32x4 w; w.x = cvt_pk_bf16(v0[0], v0[1]); w.y = cvt_pk_bf16(v0[2], v0[3]); w.z = cvt_pk_bf16(v1[0], v1[1]); w.w = cvt_pk_bf16(v1[2], v1[3]);
                    *(u32x4*)(rowp + bj * HALF) = w; } }
    }
};
struct ProbE1 {
    static constexpr int STAMP_ID = 6;
    static constexpr int K = D, ROWB = 2 * D; static constexpr bool PERM = true, HOOK = true, F8 = false, DENSE = true;
    const bf16* A; const bf16* Bt; const bf16* PJ; bf16* O; int G, c;
    __device__ __forceinline__ bool next(int i, Unit& u) const { const int L = i * G + c; if (L >= 64 * 4) return false; u.pm = L >> 2; u.pn = L & 3; u.e = 0; u.rb = 0; return true; }
    __device__ __forceinline__ const char* a_base(const Unit& u) const { return (const char*)A + (size_t)u.pm * BM * K * 2; }
    __device__ __forceinline__ void a_offs(const Unit&, const int (&R)[2], const int (&C)[2], unsigned (&v)[2][2]) const {
#pragma unroll
        for (int h = 0; h < 2; ++h)
#pragma unroll
            for (int i = 0; i < 2; ++i) v[h][i] = (unsigned)((h * HALF + R[i]) * K + C[i]) * 2u; }
    __device__ __forceinline__ const char* b_base(const Unit& u) const { return (const char*)Bt + (size_t)u.pn * BM * K * 2; }
    __device__ __forceinline__ void hook(f32x4 (&acc)[2][2][4][2], const Unit& u, int wr, int wc, int fr, int fq) const {
        int row0 = u.pm * BM + wr * 64 + fr, col0 = u.pn * BM + wc * 32 + 8 * fq;
        asm volatile("" : "+v"(row0), "+v"(col0));
#pragma unroll
        for (int ai = 0; ai < 2; ++ai) {
            u32x4 ga[4][2], gb[4][2];
#pragma unroll
            for (int m = 0; m < 4; ++m) { const bf16* rowp = PJ + (size_t)(row0 + ai * HALF + m * 16) * NPROJ + col0;
#pragma unroll
                for (int bj = 0; bj < 2; ++bj) { ga[m][bj] = *(const u32x4*)(rowp + P_GA + bj * HALF); gb[m][bj] = *(const u32x4*)(rowp + P_GB + bj * HALF); } }
#pragma unroll
            for (int m = 0; m < 4; ++m)
#pragma unroll
                for (int bj = 0; bj < 2; ++bj)
#pragma unroll
                    for (int q = 0; q < 4; ++q) { const float a0 = bf2f(ga[m][bj][q] & 0xffffu), a1 = bf2f(ga[m][bj][q] >> 16), b0 = bf2f(gb[m][bj][q] & 0xffffu), b1 = bf2f(gb[m][bj][q] >> 16);
                        const float r0 = (1.f + __expf(-b0)) / (1.f + __expf(-a0)), r1 = (1.f + __expf(-b1)) / (1.f + __expf(-a1));
                        acc[ai][bj][m][q >> 1][(q & 1) * 2] *= r0; acc[ai][bj][m][q >> 1][(q & 1) * 2 + 1] *= r1; }
            asm volatile("" ::: "memory"); }
    }
    __device__ __forceinline__ void epi(const f32x4 (&acc)[2][2][4][2], const Unit& u, int wr, int wc, int fr, int fq) const {
        int row0 = u.pm * BM + wr * 64 + fr, col0 = u.pn * BM + wc * 32 + 8 * fq;
        asm volatile("" : "+v"(row0), "+v"(col0));
#pragma unroll
        for (int ai = 0; ai < 2; ++ai) {
            u32x4 gb[4][2];
#pragma unroll
            for (int m = 0; m < 4; ++m)
#pragma unroll
                for (int bj = 0; bj < 2; ++bj) gb[m][bj] = *(const u32x4*)(PJ + (size_t)(row0 + ai * HALF + m * 16) * NPROJ + col0 + P_GB + bj * HALF);
#pragma unroll
            for (int m = 0; m < 4; ++m) { const size_t r = (size_t)(row0 + ai * HALF + m * 16);
#pragma unroll
                for (int bj = 0; bj < 2; ++bj) { float v[8];
#pragma unroll
                    for (int q = 0; q < 4; ++q) { v[2 * q] = acc[ai][bj][m][q >> 1][(q & 1) * 2] * sigmf(bf2f(gb[m][bj][q] & 0xffffu)); v[2 * q + 1] = acc[ai][bj][m][q >> 1][(q & 1) * 2 + 1] * sigmf(bf2f(gb[m][bj][q] >> 16)); }
                    u32x4 w; w.x = cvt_pk_bf16(v[0], v[1]); w.y = cvt_pk_bf16(v[2], v[3]); w.z = cvt_pk_bf16(v[4], v[5]); w.w = cvt_pk_bf16(v[6], v[7]);
                    *(u32x4*)(O + r * D + col0 + bj * HALF) = w; } }
            asm volatile("" ::: "memory"); }
    }
};
struct ProbE2 {
    static constexpr int STAMP_ID = 7;
    static constexpr int K = D, ROWB = 2 * D; static constexpr bool PERM = false, HOOK = false, F8 = false, DENSE = true;
    const bf16* A; const bf16* Bt; const float* X; const float* mod; float* O; int G, c;
    __device__ __forceinline__ bool next(int i, Unit& u) const { const int L = i * G + c; if (L >= 64 * 4) return false; u.pm = L >> 2; u.pn = L & 3; u.e = 0; u.rb = 0; return true; }
    __device__ __forceinline__ const char* a_base(const Unit& u) const { return (const char*)A + (size_t)u.pm * BM * K * 2; }
    __device__ __forceinline__ void a_offs(const Unit&, const int (&R)[2], const int (&C)[2], unsigned (&v)[2][2]) const {
#pragma unroll
        for (int h = 0; h < 2; ++h)
#pragma unroll
            for (int i = 0; i < 2; ++i) v[h][i] = (unsigned)((h * HALF + R[i]) * K + C[i]) * 2u; }
    __device__ __forceinline__ const char* b_base(const Unit& u) const { return (const char*)Bt + (size_t)u.pn * BM * K * 2; }
    __device__ __forceinline__ void hook(f32x4 (&)[2][2][4][2], const Unit&, int, int, int, int) const {}
    __device__ __forceinline__ void epi(const f32x4 (&acc)[2][2][4][2], const Unit& u, int wr, int wc, int fr, int fq) const {
        const int row0 = u.pm * BM + wr * 64 + fr, col0 = u.pn * BM + wc * 32 + 4 * fq;
        const float* g1 = mod + (size_t)(u.pm / 8) * 6 * D + 2 * D;
        f32x4 gv[2][2];
#pragma unroll
        for (int bj = 0; bj < 2; ++bj)
#pragma unroll
            for (int n = 0; n < 2; ++n) gv[bj][n] = *(const f32x4*)(g1 + col0 + bj * HALF + n * 16);
#pragma unroll
        for (int ai = 0; ai < 2; ++ai) {
            f32x4 xv[4][2][2];
#pragma unroll
            for (int m = 0; m < 4; ++m) { const size_t off = (size_t)(row0 + ai * HALF + m * 16) * D + col0;
#pragma unroll
                for (int bj = 0; bj < 2; ++bj)
#pragma unroll
                    for (int n = 0; n < 2; ++n) xv[m][bj][n] = __builtin_nontemporal_load((const f32x4*)(X + off + bj * HALF + n * 16)); }
#pragma unroll
            for (int m = 0; m < 4; ++m) { const size_t off = (size_t)(row0 + ai * HALF + m * 16) * D + col0;
#pragma unroll
                for (int bj = 0; bj < 2; ++bj)
#pragma unroll
                    for (int n = 0; n < 2; ++n) *(f32x4*)(O + off + bj * HALF + n * 16) = xv[m][bj][n] + gv[bj][n] * acc[ai][bj][m][n]; }
            asm volatile("" ::: "memory"); }
    }
};
__device__ __forceinline__ void moe_tile_starts(Frame& F, volatile LAS int* mts) {
    if (F.tid == 0) { const unsigned* cnt = (const unsigned*)(F.ws + WS_CTL) + CW_CNT; int s = 0;
        for (int e = 0; e < E; ++e) { mts[e] = s; s += (int)((cnt[e * 64] + 255u) >> 8); } mts[E] = s; }
    __syncthreads();
}
__device__ __forceinline__ int moe_find_expert(const volatile LAS int* mts, int mt) { int e = 0;
#pragma unroll
    for (int s = 16; s > 0; s >>= 1) { if (mts[e + s] <= mt) e += s; }
    return e; }
constexpr float SC_H = 16.f, SC_W = 256.f, SC_ACT = 4.f, SC_Y = 32.f;
struct ProbMoe1 {
    static constexpr int STAMP_ID = 9;
    static constexpr int K = D, ROWB = D; static constexpr bool PERM = true, HOOK = false, F8 = true, DENSE = false;
    const unsigned char* A; const unsigned char* Bt; unsigned char* O; const float* b1; const int* tokl; const unsigned* cnt; const volatile LAS int* mts; int G, c, total;
    __device__ __forceinline__ bool next(int i, Unit& u) const {
        int mt, pn; if (G == 256) { const int x = c & 7, sl = c >> 3; mt = ((i * 8 + x) << 2) + (sl >> 3); pn = sl & 7; }
        else { const int L = i * G + c; mt = L >> 3; pn = L & 7; }
        if (mt >= total) return false;
        u.pm = mt; u.pn = pn; u.e = __builtin_amdgcn_readfirstlane(moe_find_expert(mts, mt)); u.rb = __builtin_amdgcn_readfirstlane((mt - mts[u.e]) * 256); return true; }
    __device__ __forceinline__ const char* a_base(const Unit&) const { return (const char*)A; }
    __device__ __forceinline__ void a_offs(const Unit& u, const int (&R)[2], const int (&C)[2], unsigned (&v)[2][2]) const {
        const int n = (int)cnt[u.e * 64]; const int* lst = tokl + (size_t)u.e * NT;
#pragma unroll
        for (int h = 0; h < 2; ++h)
#pragma unroll
            for (int i = 0; i < 2; ++i) { const int idx = u.rb + h * HALF + R[i]; const int tok = idx < n ? lst[idx] : 0; v[h][i] = (unsigned)(tok * ROWB + C[i] * 2); } }
    __device__ __forceinline__ const char* b_base(const Unit& u) const { return (const char*)Bt + ((size_t)u.e * 2 * FF + (size_t)u.pn * BM) * ROWB; }
    __device__ __forceinline__ void hook(f32x4 (&)[2][2][4][2], const Unit&, int, int, int, int) const {}
    __device__ __forceinline__ void epi(const f32x4 (&acc)[2][2][4][2], const Unit& u, int wr, int wc, int fr, int fq) const {
        int row0 = u.pm * BM + wr * 64 + fr, col0 = u.pn * 128 + wc * 32 + 8 * fq;
        asm volatile("" : "+v"(row0), "+v"(col0));
        const float* bg = b1 + (size_t)u.e * 2 * FF + col0; f32x4 bgv[2], buv[2];
#pragma unroll
        for (int n = 0; n < 2; ++n) { bgv[n] = *(const f32x4*)(bg + 4 * n); buv[n] = *(const f32x4*)(bg + FF + 4 * n); }
        constexpr float inv = 1.f / (SC_H * SC_W);
#pragma unroll
        for (int ai = 0; ai < 2; ++ai)
#pragma unroll
            for (int m = 0; m < 4; ++m) { float v[8];
#pragma unroll
                for (int n = 0; n < 2; ++n)
#pragma unroll
                    for (int j = 0; j < 4; ++j) { const float gt = fminf(acc[ai][0][m][n][j] * inv + bgv[n][j], 7.f); const float up = fminf(fmaxf(acc[ai][1][m][n][j] * inv + buv[n][j], -7.f), 7.f);
                        v[4 * n + j] = (up + 1.f) * gt * sigmf(1.702f * gt) * SC_ACT; }
                u32x2 w; w.x = pk4_fp8(v[0], v[1], v[2], v[3]); w.y = pk4_fp8(v[4], v[5], v[6], v[7]);
                *(u32x2*)(O + (size_t)(row0 + ai * HALF + m * 16) * FF + col0) = w; }
    }
};
struct ProbMoe2 {
    static constexpr int STAMP_ID = 10;
    static constexpr int K = FF, ROWB = FF; static constexpr bool PERM = true, HOOK = false, F8 = true, DENSE = true;
    const unsigned char* A; const unsigned char* Bt; unsigned char* O; const float* b2; const float* gatel; const unsigned* cnt; const volatile LAS int* mts; int G, c, total;
    __device__ __forceinline__ bool next(int i, Unit& u) const {
        int mt, pn; if (G == 256) { const int x = c & 7, sl = c >> 3; mt = ((i * 8 + x) << 3) + (sl >> 2); pn = sl & 3; }
        else { const int L = i * G + c; mt = L >> 2; pn = L & 3; }
        if (mt >= total) return false;
        u.pm = mt; u.pn = pn; u.e = __builtin_amdgcn_readfirstlane(moe_find_expert(mts, mt)); u.rb = __builtin_amdgcn_readfirstlane((mt - mts[u.e]) * 256); return true; }
    __device__ __forceinline__ const char* a_base(const Unit& u) const { return (const char*)A + (size_t)u.pm * BM * ROWB; }
    __device__ __forceinline__ void a_offs(const Unit&, const int (&R)[2], const int (&C)[2], unsigned (&v)[2][2]) const {
#pragma unroll
        for (int h = 0; h < 2; ++h)
#pragma unroll
            for (int i = 0; i < 2; ++i) v[h][i] = (unsigned)((h * HALF + R[i]) * ROWB + C[i] * 2); }
    __device__ __forceinline__ const char* b_base(const Unit& u) const { return (const char*)Bt + ((size_t)u.e * D + (size_t)u.pn * BM) * ROWB; }
    __device__ __forceinline__ void hook(f32x4 (&)[2][2][4][2], const Unit&, int, int, int, int) const {}
    __device__ __forceinline__ void epi(const f32x4 (&acc)[2][2][4][2], const Unit& u, int wr, int wc, int fr, int fq) const {
        int rloc = wr * 64 + fr, col0 = u.pn * BM + wc * 32 + 8 * fq;
        asm volatile("" : "+v"(rloc), "+v"(col0));
        const int n = (int)cnt[u.e * 64];
        const float* bb = b2 + (size_t)u.e * D + col0; const float* gl = gatel + (size_t)u.e * NT;
        constexpr float inv = 1.f / (SC_ACT * SC_W);
        f32x4 bv[2][2];
#pragma unroll
        for (int bj = 0; bj < 2; ++bj)
#pragma unroll
            for (int q = 0; q < 2; ++q) bv[bj][q] = *(const f32x4*)(bb + bj * HALF + 4 * q);
#pragma unroll
        for (int ai = 0; ai < 2; ++ai)
#pragma unroll
            for (int m = 0; m < 4; ++m) { const int rl = rloc + ai * HALF + m * 16; const int idx = u.rb + rl; const float gt = idx < n ? gl[idx] : 0.f;
                unsigned char* rowp = O + (size_t)(u.pm * BM + rl) * D + col0; const float gs = gt * SC_Y;
#pragma unroll
                for (int bj = 0; bj < 2; ++bj) { const f32x4 v0 = (acc[ai][bj][m][0] * inv + bv[bj][0]) * gs, v1 = (acc[ai][bj][m][1] * inv + bv[bj][1]) * gs;
                    u32x2 w; w.x = pk4_fp8(v0[0], v0[1], v0[2], v0[3]); w.y = pk4_fp8(v1[0], v1[1], v1[2], v1[3]);
                    *(u32x2*)(rowp + bj * HALF) = w; } }
    }
};
__device__ __forceinline__ void final_phase(Frame& F, const Args& A, const volatile LAS int* mts) {
    const int gw = F.vcu * NWAVES + F.wave, NGW = F.G * NWAVES, lane = F.lane;
    const float* mod = (const float*)(F.ws + WS_MOD); const int* asg = (const int*)(F.ws + WS_ASG); const unsigned char* Y2 = (const unsigned char*)(F.ws + WS_Y2); const float* fw = A.in[23];
    for (int row = gw; row < NT; row += NGW) {
        const float* g2 = mod + (size_t)(row / T) * 6 * D + 5 * D;
        f32x4 v[4]; f32x4 m[4];
#pragma unroll
        for (int j = 0; j < 4; ++j) m[j] = (f32x4){0.f, 0.f, 0.f, 0.f};
#pragma unroll
        for (int k = 0; k < 4; ++k) { const int a = asg[row * 4 + k]; const int e = a >> 16, pos = a & 0xffff; const size_t slot = (size_t)mts[e] * 256 + pos;
            const unsigned* yp = (const unsigned*)(Y2 + slot * D) + lane;
#pragma unroll
            for (int j = 0; j < 4; ++j) { const int w = (int)__builtin_nontemporal_load(yp + 64 * j); const f32x2 lo = __builtin_amdgcn_cvt_pk_f32_fp8(w, false), hi = __builtin_amdgcn_cvt_pk_f32_fp8(w, true);
                m[j].x += lo.x; m[j].y += lo.y; m[j].z += hi.x; m[j].w += hi.y; } }
        float ss = 0.f;
#pragma unroll
        for (int j = 0; j < 4; ++j) { const f32x4 xv = __builtin_nontemporal_load((const f32x4*)(A.out + (size_t)row * D) + lane + 64 * j); const f32x4 gv = *((const f32x4*)g2 + lane + 64 * j);
            v[j] = xv + gv * (m[j] * (1.f / SC_Y)); ss += (v[j].x * v[j].x + v[j].y * v[j].y) + (v[j].z * v[j].z + v[j].w * v[j].w); }
        const float rstd = rsqrtf(wave_sum(ss) * (1.f / D) + EPS);
#pragma unroll
        for (int j = 0; j < 4; ++j) { const f32x4 wv = *((const f32x4*)fw + lane + 64 * j); __builtin_nontemporal_store(v[j] * rstd * wv, (f32x4*)(A.out + (size_t)row * D) + lane + 64 * j); }
    }
}
typedef short s16x4 __attribute__((ext_vector_type(4)));
constexpr int NA_VLAT = 0, NA_VCTX = 65536, NA_KCTX = 98304, NA_MRG = 131072, NA_MRG_W = 2304, NA_RPB = NA_MRG + 4 * NA_MRG_W, NA_END = NA_RPB + 15 * 32 * 4;
__device__ __forceinline__ void na_phase(Frame& F, const Args& A, int blk, int nblk) {
    const bf16* PJ = (const bf16*)(F.ws + WS_PROJ); bf16* OC = (bf16*)(F.ws + WS_OCAT); const float* rpb = A.in[8];
    const int tid = F.tid, lane = F.lane, wave = F.wave, g = lane >> 4, li = lane & 15;
    const int qb = wave & 3, half = wave >> 2;
    const int w0 = (qb == 0) ? 0 : (qb == 1) ? 8 : (qb == 2) ? 24 : 32;
    LAS unsigned char* lds = F.lds;
    LAS float* rpbs = (LAS float*)(lds + NA_RPB);
    LAS unsigned char* mrgb = lds + NA_MRG + qb * NA_MRG_W;
    unsigned kdl[2], vdl;
#pragma unroll
    for (int p = 0; p < 2; ++p) kdl[p] = (unsigned)((lane >> 3) * (NPROJ * 2) + 16 * ((lane & 7) ^ ((4 * p + (lane >> 4)) & 7)));
    vdl = (unsigned)((lane >> 3) * (NPROJ * 2) + 16 * (((((lane & 7) >> 1) ^ ((lane >> 4) & 3)) << 1) | (lane & 1)));
    const int ntask = NB * H * 32;
    const int t_lo = (int)((long)ntask * blk / nblk), t_hi = (int)((long)ntask * (blk + 1) / nblk);
    const int fl = (2 * (g & 1) + ((li >> 2) >> 1)) & 3;
    int cur_bh = -1;
    for (int task = t_lo; task < t_hi; ++task) {
        const int bh = task >> 5, r = task & 31, b = bh >> 3, h = bh & 7;
        const int r0 = min(max(r - 4, 0), 24);
        __syncthreads();
        if (bh != cur_bh) {
            cur_bh = bh;
            const unsigned char* kc = (const unsigned char*)(PJ + (size_t)(NT + b * LC) * NPROJ + P_NAK + h * 64); const unsigned char* vc = (const unsigned char*)(PJ + (size_t)(NT + b * LC) * NPROJ + P_NAV + h * 64);
#pragma unroll
            for (int i = 0; i < 4; ++i) { const int pc = wave * 4 + i; unsigned vo = kdl[pc & 1]; asm volatile("" : "+v"(vo));
                __builtin_amdgcn_global_load_lds((const unsigned*)(kc + (size_t)pc * 8 * (NPROJ * 2) + vo), (LAS unsigned*)(lds + NA_KCTX + pc * 1024), 16, 0, 0);
                unsigned vv = vdl; asm volatile("" : "+v"(vv));
                __builtin_amdgcn_global_load_lds((const unsigned*)(vc + (size_t)pc * 8 * (NPROJ * 2) + vv), (LAS unsigned*)(lds + NA_VCTX + pc * 1024), 16, 0, 0); }
            if (tid < 15 * 32) { const int dr = tid >> 5, dc = tid & 31; rpbs[tid] = dc < 31 ? rpb[(h * 15 + dr) * 31 + dc] : 0.f; }
        }
        { const unsigned char* kb = (const unsigned char*)(PJ + (size_t)(b * T + r0 * 64) * NPROJ + P_NAK + h * 64);
#pragma unroll
            for (int i = 0; i < 8; ++i) { const int pc = wave * 8 + i; unsigned vo = kdl[pc & 1]; asm volatile("" : "+v"(vo));
                __builtin_amdgcn_global_load_lds((const unsigned*)(kb + (size_t)pc * 8 * (NPROJ * 2) + vo), (LAS unsigned*)(lds + NA_VLAT + pc * 1024), 16, 0, 0); } }
        const bf16* qp = PJ + (size_t)(b * T + r * 64 + 16 * qb + li) * NPROJ + P_NAQ + h * 64 + 8 * g;
        const bf16x8 Qf0 = *(const bf16x8*)qp, Qf1 = *(const bf16x8*)(qp + 32);
        asm volatile("s_waitcnt vmcnt(0)" ::: "memory");
        __syncthreads();
        f32x4 st[16];
        const int qc = 16 * qb + li, c0 = min(max(qc - 8, 0), 48);
        { const LAS unsigned char* kbase = lds + (half ? NA_KCTX : NA_VLAT);
#pragma unroll
            for (int hb = 0; hb < 2; ++hb) {
                bf16x8 Kf[8][2];
#pragma unroll
                for (int tt = 0; tt < 8; ++tt) { const int t = 8 * hb + tt; const int key = half ? (16 * t + li) : ((t >> 1) * 64 + w0 + 16 * (t & 1) + li); const int xs = (key >> 1) & 7;
                    Kf[tt][0] = *(const LAS bf16x8*)(kbase + key * 128 + 16 * (g ^ xs)); Kf[tt][1] = *(const LAS bf16x8*)(kbase + key * 128 + 16 * ((4 + g) ^ xs)); }
                __builtin_amdgcn_sched_barrier(0);
#pragma unroll
                for (int tt = 0; tt < 8; ++tt) { f32x4 acc = (f32x4){0.f, 0.f, 0.f, 0.f};
                    acc = __builtin_amdgcn_mfma_f32_16x16x32_bf16(Kf[tt][0], Qf0, acc, 0, 0, 0); acc = __builtin_amdgcn_mfma_f32_16x16x32_bf16(Kf[tt][1], Qf1, acc, 0, 0, 0); st[8 * hb + tt] = acc; }
                __builtin_amdgcn_sched_barrier(0);
            } }
        LDS_WAIT();
        __syncthreads();
        { const unsigned char* vb = (const unsigned char*)(PJ + (size_t)(b * T + r0 * 64) * NPROJ + P_NAV + h * 64);
#pragma unroll
            for (int i = 0; i < 8; ++i) { const int pc = wave * 8 + i; unsigned vv = vdl; asm volatile("" : "+v"(vv));
                __builtin_amdgcn_global_load_lds((const unsigned*)(vb + (size_t)pc * 8 * (NPROJ * 2) + vv), (LAS unsigned*)(lds + NA_VLAT + pc * 1024), 16, 0, 0); } }
        float mx = -3.0e38f;
        if (half == 0) {
#pragma unroll
            for (int t = 0; t < 16; ++t) { const int dr = r0 + (t >> 1) - r + 7;
#pragma unroll
                for (int rr = 0; rr < 4; ++rr) { const int kc = w0 + 16 * (t & 1) + 4 * g + rr; const bool valid = (kc >= c0) && (kc < c0 + 16);
                    const int dc = min(max(kc - qc + 15, 0), 30);
                    const float sb = st[t][rr] * 0.125f + rpbs[dr * 32 + dc];
                    const float s = valid ? sb : -1.0e30f; st[t][rr] = s; mx = fmaxf(mx, s); } }
        } else {
#pragma unroll
            for (int t = 0; t < 16; ++t)
#pragma unroll
                for (int rr = 0; rr < 4; ++rr) { const float s = st[t][rr] * 0.125f; st[t][rr] = s; mx = fmaxf(mx, s); }
        }
        mx = fmaxf(mx, __shfl_xor(mx, 16)); mx = fmaxf(mx, __shfl_xor(mx, 32));
        float sum = 0.f;
#pragma unroll
        for (int t = 0; t < 16; ++t)
#pragma unroll
            for (int rr = 0; rr < 4; ++rr) { const float p = __expf(st[t][rr] - mx); st[t][rr] = p; sum += p; }
        sum += __shfl_xor(sum, 16); sum += __shfl_xor(sum, 32);
        asm volatile("s_waitcnt vmcnt(0)" ::: "memory");
        __syncthreads();
        f32x4 o[4];
#pragma unroll
        for (int dt = 0; dt < 4; ++dt) o[dt] = (f32x4){0.f, 0.f, 0.f, 0.f};
        const int vrow0 = half ? (4 * g + (li >> 2)) : (w0 + 4 * g + (li >> 2));
        const unsigned vbase = (half ? NA_VCTX : NA_VLAT) + vrow0 * 128 + (li & 3) * 8;
        const int sstep = half ? 32 * 128 : 64 * 128;
#pragma unroll
        for (int s8 = 0; s8 < 8; ++s8) {
            u32x4 pw; pw.x = cvt_pk_bf16(st[2 * s8][0], st[2 * s8][1]); pw.y = cvt_pk_bf16(st[2 * s8][2], st[2 * s8][3]);
            pw.z = cvt_pk_bf16(st[2 * s8 + 1][0], st[2 * s8 + 1][1]); pw.w = cvt_pk_bf16(st[2 * s8 + 1][2], st[2 * s8 + 1][3]);
            const bf16x8 Pf = __builtin_bit_cast(bf16x8, pw);
#pragma unroll
            for (int dt = 0; dt < 4; ++dt) {
                const s16x4 v0 = __builtin_amdgcn_ds_read_tr16_b64_v4i16((LAS s16x4*)(lds + vbase + s8 * sstep + (dt ^ fl) * 32));
                const s16x4 v1 = __builtin_amdgcn_ds_read_tr16_b64_v4i16((LAS s16x4*)(lds + vbase + s8 * sstep + 16 * 128 + (dt ^ fl) * 32));
                bf16x8 Vf; Vf[0] = v0[0]; Vf[1] = v0[1]; Vf[2] = v0[2]; Vf[3] = v0[3]; Vf[4] = v1[0]; Vf[5] = v1[1]; Vf[6] = v1[2]; Vf[7] = v1[3];
                o[dt] = __builtin_amdgcn_mfma_f32_16x16x32_bf16(Pf, Vf, o[dt], 0, 0, 0);
            }
        }
        LAS bf16* mo = (LAS bf16*)mrgb; LAS float* mml = (LAS float*)(mrgb + 2048);
        if (half == 1) {
#pragma unroll
            for (int dt = 0; dt < 4; ++dt)
#pragma unroll
                for (int rr = 0; rr < 4; ++rr) mo[(dt * 4 + rr) * 64 + lane] = (bf16)f2bf(o[dt][rr]);
            if (lane < 16) { mml[lane] = mx; mml[16 + lane] = sum; }
        }
        __syncthreads();
        if (half == 0) {
            const float m2 = mml[li], l2 = mml[16 + li];
            const float M = fmaxf(mx, m2), a1 = __expf(mx - M), a2 = __expf(m2 - M), inv = 1.f / (sum * a1 + l2 * a2);
            const float f1 = a1 * inv, f2 = a2 * inv;
            float res[4][4];
#pragma unroll
            for (int rr = 0; rr < 4; ++rr) { const float f1q = __shfl(f1, 4 * g + rr), f2q = __shfl(f2, 4 * g + rr);
#pragma unroll
                for (int dt = 0; dt < 4; ++dt) res[dt][rr] = o[dt][rr] * f1q + bf2f(mo[(dt * 4 + rr) * 64 + lane]) * f2q; }
            LDS_WAIT(); asm volatile("" ::: "memory");
            LAS bf16* ot = mo;
#pragma unroll
            for (int dt = 0; dt < 4; ++dt)
#pragma unroll
                for (int rr = 0; rr < 4; ++rr) ot[(4 * g + rr) * 64 + 16 * dt + li] = (bf16)f2bf(res[dt][rr]);
            LDS_WAIT(); asm volatile("" ::: "memory");
#pragma unroll
            for (int i = 0; i < 2; ++i) { const int ch = lane + 64 * i, q = ch >> 3, c = ch & 7;
                const u32x4 v = *(const LAS u32x4*)(ot + q * 64 + 8 * c);
                *(u32x4*)(OC + (size_t)(b * T + r * 64 + 16 * qb + q) * D + h * 64 + 8 * c) = v; }
        }
    }
}
constexpr int DN_REC = 40960, DN_NCH = 36;
constexpr size_t WS_GL = 13 * MiB;
constexpr int DL_Q = 0, DL_K = 16384, DL_V = 32768, DL_KB = 49152, DL_QB = 58368, DL_KK = 67584, DL_QK = 84224, DL_AM = 100864, DL_SM = 135680;
constexpr int DL_AMS = 68;
__device__ __forceinline__ int dn_nat(int p) { return 32 * (p >> 5) + 16 * ((p & 7) >> 2) + 4 * ((p >> 3) & 3) + (p & 3); }

constexpr int DL_TL = DL_KB, DL_WIMG = DL_KK, DL_CW = DL_SM + 2560;
__device__ __forceinline__ bf16x8 dn_frag4(float a, float b, float c, float d) { u32x4 w; w.x = cvt_pk_bf16(a, b); w.y = cvt_pk_bf16(c, d); w.z = 0u; w.w = 0u; return __builtin_bit_cast(bf16x8, w); }

__device__ __forceinline__ void dn_prep(Frame& F, const Args& A) {
    const bf16* PJ = (const bf16*)(F.ws + WS_PROJ); const float* convw = A.in[9];
    const float* GG = (const float*)(F.ws + WS_G); const float* BETA = (const float*)(F.ws + WS_BETA); const float* rope = (const float*)(F.ws + WS_ROPE);
    unsigned char* DNOP = F.ws + WS_DNOP; float* GL = (float*)(F.ws + WS_GL);
    LAS unsigned char* lds = F.lds; const int tid0 = F.tid, wave = F.wave;
    LAS float* Qs = (LAS float*)(lds + DL_Q); LAS float* Ks = (LAS float*)(lds + DL_K); LAS float* Vs = (LAS float*)(lds + DL_V);
    LAS bf16* KB = (LAS bf16*)(lds + DL_KB); LAS bf16* QB = (LAS bf16*)(lds + DL_QB);
    LAS float* KK = (LAS float*)(lds + DL_KK); LAS float* QKM = (LAS float*)(lds + DL_QK); LAS float* AM = (LAS float*)(lds + DL_AM);
    LAS float* gcum = (LAS float*)(lds + DL_SM); LAS float* bet = gcum + 128; LAS float* eg = gcum + 256; LAS float* et = gcum + 384; LAS float* beg = gcum + 512;
    LAS float* TL = (LAS float*)(lds + DL_TL); LAS float* CW = (LAS float*)(lds + DL_CW);
    const int ntask = NB * H * DN_NCH;
    const bool blocked = (F.G == 256);
    const int nloc = blocked ? 9 : (ntask - (int)blockIdx.x + F.G - 1) / F.G;
#define DN_TASK(k) (blocked ? ((int)blockIdx.x >> 2) * DN_NCH + ((int)blockIdx.x & 3) * 9 + (k) : (int)blockIdx.x + (k) * F.G)
#define DN_PREFETCH(kk, tv) do { const bool _ok = (kk) < nloc; const int _tk = _ok ? DN_TASK(kk) : 0; const int _it = (tv); \
        _Pragma("unroll") for (int _r = 0; _r < 8; ++_r) pre[_r] = (u32x4){0u, 0u, 0u, 0u}; \
        if (_ok && _it < 384) { const int _bh = _tk / DN_NCH, _j = _tk % DN_NCH, _b = _bh >> 3, _h = _bh & 7; const bool _lat = _j >= 4; \
            const int _t0 = _lat ? (_j - 4) * 64 : _j * 64, _tlen = _lat ? T : LC, _rb = _lat ? _b * T : NT + _b * LC; const int _c = _it % 24, _tq = _it / 24, _ch = (_c >> 3) * 512 + _h * 64 + (_c & 7) * 8; \
            _Pragma("unroll") for (int _r = 0; _r < 8; ++_r) { const int _s = _t0 + 4 * _tq - 2 + _r; if (_s >= 0 && _s < _tlen) pre[_r] = __builtin_nontemporal_load((const u32x4*)(PJ + (size_t)(_rb + _s) * NPROJ + P_DQ + _ch)); } } } while (0)
    u32x4 pre[8];
    DN_PREFETCH(0, tid0);
    int cur_h = -1;
    for (int kt = 0; kt < nloc; ++kt) {
        const int task = DN_TASK(kt);
        const int bh = task / DN_NCH, j = task % DN_NCH, b = bh >> 3, h = bh & 7;
        const bool lat = j >= 4; const int t0 = lat ? (j - 4) * 64 : j * 64, rowbase = lat ? b * T : NT + b * LC;
        int tid = tid0; asm volatile("" : "+v"(tid));
        const int lane = tid & 63, g = lane >> 4, li = lane & 15;
        __syncthreads();
        if (h != cur_h) { cur_h = h; for (int u = tid; u < 960; u += NTHR) { const int tp = u / 192, q = u % 192; CW[u] = convw[tp * 1536 + (q >> 6) * 512 + h * 64 + (q & 63)]; } __syncthreads(); }
        if (tid < 384) { const int it = tid; const int c = it % 24, tq = it / 24, part = c >> 3, d0 = (c & 7) * 8;
            float xin[8][8];
#pragma unroll
            for (int rr = 0; rr < 8; ++rr) { const u32x4 w = pre[rr];
#pragma unroll
                for (int e = 0; e < 4; ++e) { xin[rr][2 * e] = bf2f(w[e] & 0xffffu); xin[rr][2 * e + 1] = bf2f(w[e] >> 16); } }
            float wt[5][8];
#pragma unroll
            for (int tp = 0; tp < 5; ++tp) { const f32x4 w0 = *(const LAS f32x4*)(CW + tp * 192 + part * 64 + d0), w1 = *(const LAS f32x4*)(CW + tp * 192 + part * 64 + d0 + 4);
#pragma unroll
                for (int e = 0; e < 4; ++e) { wt[tp][e] = w0[e]; wt[tp][4 + e] = w1[e]; } }
            LAS float* dst = (part == 0 ? Qs : part == 1 ? Ks : Vs);
#pragma unroll
            for (int tt = 0; tt < 4; ++tt) { float o[8];
#pragma unroll
                for (int e = 0; e < 8; ++e) { float a = 0.f;
#pragma unroll
                    for (int tp = 0; tp < 5; ++tp) a += xin[tt + tp][e] * wt[tp][e];
                    o[e] = a / (1.f + __expf(-a)); }
                *(LAS f32x4*)(dst + (4 * tq + tt) * 64 + d0) = (f32x4){o[0], o[1], o[2], o[3]}; *(LAS f32x4*)(dst + (4 * tq + tt) * 64 + d0 + 4) = (f32x4){o[4], o[5], o[6], o[7]}; } }
        DN_PREFETCH(kt + 1, tid);
        __syncthreads();
        { const int row = tid >> 2, qr = tid & 3; const bool isq = row < 64; const int tok = row & 63;
            LAS float* X = (isq ? Qs : Ks) + tok * 64 + qr * 8; LAS bf16* Y = (isq ? QB : KB) + tok * 72 + qr * 8;
            const f32x4 a0 = *(const LAS f32x4*)X, a1 = *(const LAS f32x4*)(X + 4), b0 = *(const LAS f32x4*)(X + 32), b1 = *(const LAS f32x4*)(X + 36);
            float x1[8] = {a0[0], a0[1], a0[2], a0[3], a1[0], a1[1], a1[2], a1[3]}, x2[8] = {b0[0], b0[1], b0[2], b0[3], b1[0], b1[1], b1[2], b1[3]};
            float ss = 0.f;
#pragma unroll
            for (int e = 0; e < 8; ++e) ss += x1[e] * x1[e] + x2[e] * x2[e];
            ss += __shfl_xor(ss, 1); ss += __shfl_xor(ss, 2);
            const float sc = rsqrtf(ss + EPS) * (isq ? 0.125f : 1.f);
            if (lat) { const float* rp = rope + (size_t)(t0 + tok) * 64 + qr * 16;
                const f32x4 r0 = *(const f32x4*)rp, r1 = *(const f32x4*)(rp + 4), r2 = *(const f32x4*)(rp + 8), r3 = *(const f32x4*)(rp + 12);
                const float cs[8] = {r0[0], r0[2], r1[0], r1[2], r2[0], r2[2], r3[0], r3[2]}, sn[8] = {r0[1], r0[3], r1[1], r1[3], r2[1], r2[3], r3[1], r3[3]};
#pragma unroll
                for (int e = 0; e < 8; ++e) { const float u = x1[e], v = x2[e]; x1[e] = (u * cs[e] - v * sn[e]) * sc; x2[e] = (u * sn[e] + v * cs[e]) * sc; } }
            else {
#pragma unroll
                for (int e = 0; e < 8; ++e) { x1[e] *= sc; x2[e] *= sc; } }
            *(LAS f32x4*)X = (f32x4){x1[0], x1[1], x1[2], x1[3]}; *(LAS f32x4*)(X + 4) = (f32x4){x1[4], x1[5], x1[6], x1[7]};
            *(LAS f32x4*)(X + 32) = (f32x4){x2[0], x2[1], x2[2], x2[3]}; *(LAS f32x4*)(X + 36) = (f32x4){x2[4], x2[5], x2[6], x2[7]};
            u32x4 w0, w1; w0.x = pk2(x1[0], x1[1]); w0.y = pk2(x1[2], x1[3]); w0.z = pk2(x1[4], x1[5]); w0.w = pk2(x1[6], x1[7]); w1.x = pk2(x2[0], x2[1]); w1.y = pk2(x2[2], x2[3]); w1.z = pk2(x2[4], x2[5]); w1.w = pk2(x2[6], x2[7]);
            *(LAS u32x4*)Y = w0; *(LAS u32x4*)(Y + 32) = w1; }
        if (wave < 2) { const int d = wave; const int tok = d ? 63 - lane : lane; const size_t row = (size_t)(rowbase + t0 + tok);
            const float gi = GG[row * 16 + d * 8 + h], bi = BETA[row * 16 + d * 8 + h]; float cs = gi;
#pragma unroll
            for (int o = 1; o < 64; o <<= 1) { const float t = __shfl_up(cs, o); if (lane >= o) cs += t; }
            const float last = __shfl(cs, 63);
            gcum[d * 64 + lane] = cs; bet[d * 64 + lane] = bi; eg[d * 64 + lane] = __expf(cs); et[d * 64 + lane] = __expf(last - cs); beg[d * 64 + lane] = bi * __expf(cs);
            const int c = d ? (lat ? 39 - j : 3 - j) : j;
            if (lane == 0) GL[(size_t)(bh * 2 + d) * DN_NCH + c] = __expf(last); }
        __syncthreads();
#pragma unroll
        for (int tl = 0; tl < 2; ++tl) { const int idx = wave * 2 + tl, mt = idx >> 2, nt = idx & 3;
            f32x4 akk = (f32x4){0.f, 0.f, 0.f, 0.f}, aqk = (f32x4){0.f, 0.f, 0.f, 0.f};
#pragma unroll
            for (int s = 0; s < 2; ++s) { const bf16x8 ka = *(const LAS bf16x8*)(KB + (16 * mt + li) * 72 + 8 * g + 32 * s), qa = *(const LAS bf16x8*)(QB + (16 * mt + li) * 72 + 8 * g + 32 * s),
                                                        kb = *(const LAS bf16x8*)(KB + (16 * nt + li) * 72 + 8 * g + 32 * s);
                akk = __builtin_amdgcn_mfma_f32_16x16x32_bf16(ka, kb, akk, 0, 0, 0); aqk = __builtin_amdgcn_mfma_f32_16x16x32_bf16(qa, kb, aqk, 0, 0, 0); }
#pragma unroll
            for (int rr = 0; rr < 4; ++rr) { KK[(16 * mt + 4 * g + rr) * 65 + 16 * nt + li] = akk[rr]; QKM[(16 * mt + 4 * g + rr) * 65 + 16 * nt + li] = aqk[rr]; } }
        __syncthreads();
        { const int i = tid >> 3, sg = tid & 7;
#pragma unroll
            for (int d = 0; d < 2; ++d) { const int pi = d ? 63 - i : i; const float gi = gcum[d * 64 + i], bi = bet[d * 64 + i]; float v[8];
#pragma unroll
                for (int e = 0; e < 8; ++e) { const int jj = sg * 8 + e, pj = d ? 63 - jj : jj; v[e] = (i > jj) ? bi * KK[pi * 65 + pj] * __expf(gi - gcum[d * 64 + jj]) : 0.f; }
                *(LAS f32x4*)(AM + d * 64 * DL_AMS + i * DL_AMS + sg * 8) = (f32x4){v[0], v[1], v[2], v[3]}; *(LAS f32x4*)(AM + d * 64 * DL_AMS + i * DL_AMS + sg * 8 + 4) = (f32x4){v[4], v[5], v[6], v[7]}; } }
        __syncthreads();
        if (wave < 2) {
            const int d = wave, I = lane >> 4, c = lane & 15; const LAS float* Ab = AM + d * 64 * DL_AMS + (16 * I) * DL_AMS + 16 * I;
            float t[16];
#pragma unroll
            for (int i = 0; i < 16; ++i) { float s0 = (i == c) ? 1.f : 0.f, s1 = 0.f;
#pragma unroll
                for (int j4 = 0; j4 < (i + 3) / 4; ++j4) { const f32x4 av = *(const LAS f32x4*)(Ab + i * DL_AMS + 4 * j4);
#pragma unroll
                    for (int e = 0; e < 4; ++e) if (4 * j4 + e < i) { if (e & 1) s1 -= av[e] * t[4 * j4 + e]; else s0 -= av[e] * t[4 * j4 + e]; } }
                t[i] = s0 + s1;
                if ((i & 3) == 3) asm volatile("" ::: "memory"); }
#pragma unroll
            for (int i = 0; i < 16; ++i) TL[(d * 4 + I) * 256 + i * 16 + c] = t[i];
        } else {
            const int t3 = tid - 128;
#pragma unroll
            for (int d = 0; d < 2; ++d) { const int cc = d ? (lat ? 39 - j : 3 - j) : j; unsigned char* rec = DNOP + ((size_t)(bh * 2 + d) * DN_NCH + cc) * DN_REC;
#pragma unroll
                for (int itk = 0; itk < 4; ++itk) { const int it = t3 + 384 * itk; const int mat = it >> 9, q9 = it & 511; float v[8];
                    if (mat < 2) { const int i = q9 >> 3, ch = q9 & 7, n0 = 32 * (ch >> 2) + 4 * (ch & 3), pi = d ? 63 - i : i;
                        if (mat == 0) { const float e = eg[d * 64 + i];
#pragma unroll
                            for (int jx = 0; jx < 8; ++jx) v[jx] = Qs[pi * 64 + n0 + 16 * (jx >> 2) + (jx & 3)] * e; }
                        else { const float gi = gcum[d * 64 + i];
#pragma unroll
                            for (int jx = 0; jx < 8; ++jx) { const int n = n0 + 16 * (jx >> 2) + (jx & 3), pj = d ? 63 - n : n; v[jx] = (i >= n) ? QKM[pi * 65 + pj] * __expf(gi - gcum[d * 64 + n]) : 0.f; } }
                        u32x4 w; w.x = pk2(v[0], v[1]); w.y = pk2(v[2], v[3]); w.z = pk2(v[4], v[5]); w.w = pk2(v[6], v[7]);
                        *(u32x4*)(rec + (mat == 0 ? 8192 : 16384) + (i * 64 + ch * 8) * 2) = w; }
                    else { const int dk = q9 & 63, ch = q9 >> 6, n0 = 32 * (ch >> 2) + 4 * (ch & 3);
#pragma unroll
                        for (int jx = 0; jx < 8; ++jx) { const int n = n0 + 16 * (jx >> 2) + (jx & 3), pn = d ? 63 - n : n; v[jx] = Ks[pn * 64 + dk] * et[d * 64 + n]; }
                        u32x4 w; w.x = pk2(v[0], v[1]); w.y = pk2(v[2], v[3]); w.z = pk2(v[4], v[5]); w.w = pk2(v[6], v[7]);
                        *(u32x4*)(rec + 24576 + (dk * 64 + ch * 8) * 2) = w; } } }
        }
        __syncthreads();
        { bf16x8 Xb[2][3]; const LAS float* Rs[2]; const LAS float* scl[2]; const LAS float* Am[2]; const LAS float* TLd[2]; unsigned char* rec[2]; LAS bf16* img[2]; int dd[2], isw[2], nt[2], pcol[2];
#pragma unroll
            for (int q = 0; q < 2; ++q) { const int item = wave * 2 + q; dd[q] = item >> 3; isw[q] = (item >> 2) & 1; nt[q] = item & 3;
                Rs[q] = (isw[q] ? Ks : Vs) + 16 * nt[q] + li; scl[q] = (isw[q] ? beg : bet) + dd[q] * 64; Am[q] = AM + dd[q] * 64 * DL_AMS; TLd[q] = TL + dd[q] * 4 * 256;
                const int cc = dd[q] ? (lat ? 39 - j : 3 - j) : j; rec[q] = DNOP + ((size_t)(bh * 2 + dd[q]) * DN_NCH + cc) * DN_REC; img[q] = (LAS bf16*)(lds + DL_WIMG + dd[q] * 8192);
                const int cdk = 16 * nt[q] + li; pcol[q] = 32 * (cdk >> 5) + 8 * ((cdk >> 2) & 3) + 4 * ((cdk >> 4) & 1) + (cdk & 3); }
#pragma unroll
            for (int I = 0; I < 4; ++I) {
                f32x4 acc[2], X[2];
#pragma unroll
                for (int q = 0; q < 2; ++q)
#pragma unroll
                    for (int r = 0; r < 4; ++r) { const int i = 16 * I + 4 * g + r, pi = dd[q] ? 63 - i : i; acc[q][r] = Rs[q][pi * 64] * scl[q][i]; }
#pragma unroll
                for (int J = 0; J < I; ++J)
#pragma unroll
                    for (int q = 0; q < 2; ++q) { const f32x4 a4 = *(const LAS f32x4*)(Am[q] + (16 * I + li) * DL_AMS + 16 * J + 4 * g);
                        acc[q] = __builtin_amdgcn_mfma_f32_16x16x32_bf16(dn_frag4(-a4[0], -a4[1], -a4[2], -a4[3]), Xb[q][J], acc[q], 0, 0, 0); }
#pragma unroll
                for (int q = 0; q < 2; ++q) { const f32x4 t4 = *(const LAS f32x4*)(TLd[q] + I * 256 + li * 16 + 4 * g);
                    X[q] = __builtin_amdgcn_mfma_f32_16x16x32_bf16(dn_frag4(t4[0], t4[1], t4[2], t4[3]), dn_frag4(acc[q][0], acc[q][1], acc[q][2], acc[q][3]), (f32x4){0.f, 0.f, 0.f, 0.f}, 0, 0, 0); }
#pragma unroll
                for (int q = 0; q < 2; ++q) {
                    if (I < 3) Xb[q][I] = dn_frag4(X[q][0], X[q][1], X[q][2], X[q][3]);
                    if (isw[q]) {
#pragma unroll
                        for (int r = 0; r < 4; ++r) img[q][(16 * I + 4 * g + r) * 64 + pcol[q]] = (bf16)f2bf(-X[q][r]); }
                    else { u32x2 w; w.x = cvt_pk_bf16(X[q][0], X[q][1]); w.y = cvt_pk_bf16(X[q][2], X[q][3]); *(u32x2*)(rec[q] + 32768 + (((nt[q] * 64 + lane) * 4 + I) * 4) * 2) = w; } }
            } }
        __syncthreads();
#pragma unroll
        for (int q = 0; q < 2; ++q) { const int ch = tid + NTHR * q, d = ch >> 9, c9 = ch & 511;
            const int cc = d ? (lat ? 39 - j : 3 - j) : j; unsigned char* rec = DNOP + ((size_t)(bh * 2 + d) * DN_NCH + cc) * DN_REC;
            *(u32x4*)(rec + c9 * 16) = *(const LAS u32x4*)(lds + DL_WIMG + d * 8192 + c9 * 16); }
    }
#undef DN_TASK
#undef DN_PREFETCH
}

constexpr int CW_FLAG = 8192;
__device__ __forceinline__ void dn_out_range(Frame& F, const Args& A, int pair, int tlo, int thi) {
    const bf16* OF16 = (const bf16*)(F.ws + WS_OF); const bf16* OB16 = OF16 + (size_t)NT * 512; const bf16* PJ = (const bf16*)(F.ws + WS_PROJ); bf16* OC = (bf16*)(F.ws + WS_OCAT); const float* nw = A.in[12];
    const int pb = pair >> 3, ph = pair & 7;
    const int hc = ph * 8 + (F.tid & 7); const f32x4 w0 = *(const f32x4*)(nw + (hc & 7) * 8), w1 = *(const f32x4*)(nw + (hc & 7) * 8 + 4);
    const int nit = (thi - tlo) * 8;
    for (int it0 = F.tid; it0 < nit; it0 += 4 * NTHR) {
        u32x4 av[4], bv[4], gw[4];
#pragma unroll
        for (int u = 0; u < 4; ++u) { const int it = min(it0 + u * NTHR, nit - 8 + (F.tid & 7)); const size_t tok = (size_t)pb * T + tlo + (it >> 3);
            av[u] = __builtin_nontemporal_load((const u32x4*)(OF16 + tok * 512 + hc * 8)); bv[u] = __builtin_nontemporal_load((const u32x4*)(OB16 + tok * 512 + hc * 8));
            gw[u] = *(const u32x4*)(PJ + tok * NPROJ + P_DG + hc * 8); }
#pragma unroll
        for (int u = 0; u < 4; ++u) { const int it = min(it0 + u * NTHR, nit - 8 + (F.tid & 7)); const size_t tok = (size_t)pb * T + tlo + (it >> 3);
            float v[8]; float ss = 0.f;
#pragma unroll
            for (int e = 0; e < 4; ++e) { v[2 * e] = bf2f(av[u][e] & 0xffffu) + bf2f(bv[u][e] & 0xffffu); v[2 * e + 1] = bf2f(av[u][e] >> 16) + bf2f(bv[u][e] >> 16); }
#pragma unroll
            for (int e = 0; e < 8; ++e) ss += v[e] * v[e];
            ss += __shfl_xor(ss, 1); ss += __shfl_xor(ss, 2); ss += __shfl_xor(ss, 4);
            const float rstd = rsqrtf(ss * (1.f / 64.f) + EPS);
            float o[8];
#pragma unroll
            for (int e = 0; e < 8; ++e) { const float z = bf2f(e & 1 ? gw[u][e >> 1] >> 16 : gw[u][e >> 1] & 0xffffu); const float wv = e < 4 ? w0[e] : w1[e - 4]; o[e] = v[e] * rstd * wv * (z / (1.f + __expf(-z))); }
            u32x4 w; w.x = pk2(o[0], o[1]); w.y = pk2(o[2], o[3]); w.z = pk2(o[4], o[5]); w.w = pk2(o[6], o[7]);
            *(u32x4*)(OC + tok * D + 512 + hc * 8) = w; }
    }
}
__device__ __forceinline__ void dn_out_items(Frame& F, const Args& A, int nb, int nna) {
    unsigned* flags = (unsigned*)(F.ws + WS_CTL) + CW_FLAG; unsigned* tmo = (unsigned*)(F.ws + WS_CTL) + CW_BAR + XB_TMO;
    for (int item = nb; item < NB * H * 3; item += nna) { const int pair = item / 3, th = item % 3;
        __syncthreads();
        if (F.tid == 0) { unsigned sp = 0; while (__hip_atomic_load(flags + pair * 16, __ATOMIC_RELAXED, __HIP_MEMORY_SCOPE_AGENT) == 0u) { __builtin_amdgcn_s_sleep(2);
                if ((++sp & 255u) == 0u) { if (xb_ld(tmo)) break; if (sp > XB_SPIN_CAP) { atomicAdd(tmo, 1u); break; } } }
            __builtin_amdgcn_fence(__ATOMIC_ACQUIRE, "agent"); asm volatile("s_waitcnt vmcnt(0)" ::: "memory"); }
        __syncthreads();
        dn_out_range(F, A, pair, (T * th) / 3, (T * (th + 1)) / 3); }
}
constexpr int SC_MAT = 8192, SC_SEQ = 4 * SC_MAT, SC_BUF = 2 * SC_SEQ;
__device__ __forceinline__ void dn_scan(Frame& F, const Args& A, int blk, int nblk, bool fold) {
    const unsigned char* DNOP = F.ws + WS_DNOP; const float* GL = (const float*)(F.ws + WS_GL);
    float* OFB = (float*)(F.ws + WS_OF);
    const int lane = F.lane, g = lane >> 4, li = lane & 15, wq = F.wave & 3, sh = F.wave >> 2;
    unsigned srcl[2];
#pragma unroll
    for (int p = 0; p < 2; ++p) srcl[p] = (unsigned)(((lane & ~7) | ((lane & 7) ^ ((4 * p + (lane >> 4)) & 7))) * 16);
    const int xs = (li >> 1) & 7;
    const int fo0 = li * 128 + 16 * (g ^ xs), fo1 = li * 128 + 16 * ((4 + g) ^ xs);
    for (int pair = blk; pair < NB * H; pair += nblk) {
        const int seq = pair * 2 + sh, sl = wq, b = seq >> 4, h = (seq >> 1) & 7, d = seq & 1;
        f32x4 S[4];
#pragma unroll
        for (int m = 0; m < 4; ++m) S[m] = (f32x4){0.f, 0.f, 0.f, 0.f};
        const int sgn = d ? -1 : 1; const int obase_s = d * NT * 512 + b * T * 512;
        LAS bf16* oscr = (LAS bf16*)(F.lds + 2 * SC_BUF + F.wave * 1024); bf16* OFB16 = (bf16*)OFB;
        const unsigned char* rec0 = DNOP + (size_t)seq * DN_NCH * DN_REC;
        u32x2 pu[4];
        __syncthreads();
#define SC_DMA(cn) do { const unsigned char* _rn = rec0 + (size_t)(cn) * DN_REC; LAS unsigned char* _db = F.lds + ((cn) & 1) * SC_BUF + sh * SC_SEQ + wq * 8192; \
        _Pragma("unroll") for (int _i = 0; _i < 8; ++_i) { unsigned _vo = srcl[_i & 1]; asm volatile("" : "+v"(_vo)); __builtin_amdgcn_global_load_lds((const unsigned*)(_rn + (wq * 8 + _i) * 1024 + _vo), (LAS unsigned*)(_db + _i * 1024), 16, 0, 2); } } while (0)
#define SC_STORE(cp) do { const int _tok0 = d ? (64 * (31 - ((cp) - 4)) + 63) : 64 * ((cp) - 4); _Pragma("unroll") for (int _hf = 0; _hf < 2; ++_hf) { \
            _Pragma("unroll") for (int _m = 0; _m < 2; ++_m) _Pragma("unroll") for (int _r = 0; _r < 4; ++_r) oscr[(16 * _m + 4 * g + _r) * 16 + li] = (bf16)f2bf(opend[2 * _hf + _m][_r]); \
            LDS_WAIT(); asm volatile("" ::: "memory"); const u32x4 _v = *(const LAS u32x4*)(oscr + (lane >> 1) * 16 + (lane & 1) * 8); LDS_WAIT(); asm volatile("" ::: "memory"); \
            *(u32x4*)(OFB16 + (size_t)obase_s + (size_t)(_tok0 + (32 * _hf + (lane >> 1)) * sgn) * 512 + h * 64 + 16 * sl + (lane & 1) * 8) = _v; } } while (0)
        SC_DMA(0);
        { const u32x4 ua = __builtin_nontemporal_load((const u32x4*)(rec0 + 32768 + (sl * 64 + lane) * 32)), ub = __builtin_nontemporal_load((const u32x4*)(rec0 + 32768 + (sl * 64 + lane) * 32 + 16));
            pu[0] = (u32x2){ua.x, ua.y}; pu[1] = (u32x2){ua.z, ua.w}; pu[2] = (u32x2){ub.x, ub.y}; pu[3] = (u32x2){ub.z, ub.w}; }
        f32x4 opend[4];
#pragma unroll
        for (int m = 0; m < 4; ++m) opend[m] = (f32x4){0.f, 0.f, 0.f, 0.f};
        for (int c = 0; c < DN_NCH; ++c) {
            const float gl = GL[(size_t)seq * DN_NCH + c];
            f32x4 vn[4];
#pragma unroll
            for (int m = 0; m < 4; ++m) vn[m] = (f32x4){bf2f(pu[m].x & 0xffffu), bf2f(pu[m].x >> 16), bf2f(pu[m].y & 0xffffu), bf2f(pu[m].y >> 16)};
            asm volatile("s_waitcnt vmcnt(0)" ::: "memory");
            __syncthreads();
            if (c + 1 < DN_NCH) { SC_DMA(c + 1);
                const unsigned char* up = rec0 + (size_t)(c + 1) * DN_REC + 32768 + (sl * 64 + lane) * 32; const u32x4 ua = __builtin_nontemporal_load((const u32x4*)up), ub = __builtin_nontemporal_load((const u32x4*)(up + 16));
                pu[0] = (u32x2){ua.x, ua.y}; pu[1] = (u32x2){ua.z, ua.w}; pu[2] = (u32x2){ub.x, ub.y}; pu[3] = (u32x2){ub.z, ub.w}; }
            if (c >= 5) SC_STORE(c - 1);
            const LAS unsigned char* sb = F.lds + (c & 1) * SC_BUF + sh * SC_SEQ;
            bf16x8 fW[4][2], fD[4][2], fK[4][2];
#pragma unroll
            for (int m = 0; m < 4; ++m) { fW[m][0] = *(const LAS bf16x8*)(sb + m * 2048 + fo0); fW[m][1] = *(const LAS bf16x8*)(sb + m * 2048 + fo1); }
            __builtin_amdgcn_sched_barrier(0);
            bf16x8 Sb[2], Vb[2];
#pragma unroll
            for (int s = 0; s < 2; ++s) { u32x4 w; w.x = cvt_pk_bf16(S[2 * s][0], S[2 * s][1]); w.y = cvt_pk_bf16(S[2 * s][2], S[2 * s][3]); w.z = cvt_pk_bf16(S[2 * s + 1][0], S[2 * s + 1][1]); w.w = cvt_pk_bf16(S[2 * s + 1][2], S[2 * s + 1][3]); Sb[s] = __builtin_bit_cast(bf16x8, w); }
#pragma unroll
            for (int m = 0; m < 4; ++m)
#pragma unroll
                for (int s = 0; s < 2; ++s) vn[m] = __builtin_amdgcn_mfma_f32_16x16x32_bf16(fW[m][s], Sb[s], vn[m], 0, 0, 0);
            if (c >= 4) {
#pragma unroll
                for (int m = 0; m < 4; ++m) { fD[m][0] = *(const LAS bf16x8*)(sb + SC_MAT + m * 2048 + fo0); fD[m][1] = *(const LAS bf16x8*)(sb + SC_MAT + m * 2048 + fo1);
                    fK[m][0] = *(const LAS bf16x8*)(sb + 2 * SC_MAT + m * 2048 + fo0); fK[m][1] = *(const LAS bf16x8*)(sb + 2 * SC_MAT + m * 2048 + fo1); } }
#pragma unroll
            for (int m = 0; m < 4; ++m) { fW[m][0] = *(const LAS bf16x8*)(sb + 3 * SC_MAT + m * 2048 + fo0); fW[m][1] = *(const LAS bf16x8*)(sb + 3 * SC_MAT + m * 2048 + fo1); }
            __builtin_amdgcn_sched_barrier(0);
#pragma unroll
            for (int s = 0; s < 2; ++s) { u32x4 w; w.x = cvt_pk_bf16(vn[2 * s][0], vn[2 * s][1]); w.y = cvt_pk_bf16(vn[2 * s][2], vn[2 * s][3]); w.z = cvt_pk_bf16(vn[2 * s + 1][0], vn[2 * s + 1][1]); w.w = cvt_pk_bf16(vn[2 * s + 1][2], vn[2 * s + 1][3]); Vb[s] = __builtin_bit_cast(bf16x8, w); }
            if (c >= 4) {
#pragma unroll
                for (int m = 0; m < 4; ++m) { f32x4 o = (f32x4){0.f, 0.f, 0.f, 0.f};
#pragma unroll
                    for (int s = 0; s < 2; ++s) { o = __builtin_amdgcn_mfma_f32_16x16x32_bf16(fD[m][s], Sb[s], o, 0, 0, 0); o = __builtin_amdgcn_mfma_f32_16x16x32_bf16(fK[m][s], Vb[s], o, 0, 0, 0); }
                    opend[m] = o; }
            }
#pragma unroll
            for (int m = 0; m < 4; ++m) { S[m] = S[m] * gl;
#pragma unroll
                for (int s = 0; s < 2; ++s) S[m] = __builtin_amdgcn_mfma_f32_16x16x32_bf16(fW[m][s], Vb[s], S[m], 0, 0, 0); }
        }
        SC_STORE(DN_NCH - 1);
#undef SC_DMA
#undef SC_STORE
        asm volatile("s_waitcnt vmcnt(0)" ::: "memory"); __syncthreads();
        if (fold) dn_out_range(F, A, pair, 0, T);
        else if (F.tid == 0) { __builtin_amdgcn_fence(__ATOMIC_RELEASE, "agent"); asm volatile("s_waitcnt vmcnt(0)" ::: "memory");
            __hip_atomic_store((unsigned*)(F.ws + WS_CTL) + CW_FLAG + pair * 16, 1u, __ATOMIC_RELAXED, __HIP_MEMORY_SCOPE_AGENT); }
    }
}
__device__ __forceinline__ void dn_out(Frame& F, const Args& A) {
    const float* OF = (const float*)(F.ws + WS_OF); const float* OB = OF + (size_t)NT * 512; const bf16* PJ = (const bf16*)(F.ws + WS_PROJ); bf16* OC = (bf16*)(F.ws + WS_OCAT); const float* nw = A.in[12];
    for (size_t it = (size_t)blockIdx.x * NTHR + F.tid; it < (size_t)NT * 64; it += (size_t)F.G * NTHR) {
        const size_t tok = it >> 6; const int hc = (int)(it & 63);
        const f32x4 a0 = *(const f32x4*)(OF + tok * 512 + hc * 8), a1 = *(const f32x4*)(OF + tok * 512 + hc * 8 + 4), b0 = *(const f32x4*)(OB + tok * 512 + hc * 8), b1 = *(const f32x4*)(OB + tok * 512 + hc * 8 + 4);
        float v[8]; float ss = 0.f;
#pragma unroll
        for (int e = 0; e < 4; ++e) { v[e] = a0[e] + b0[e]; v[4 + e] = a1[e] + b1[e]; }
#pragma unroll
        for (int e = 0; e < 8; ++e) ss += v[e] * v[e];
        ss += __shfl_xor(ss, 1); ss += __shfl_xor(ss, 2); ss += __shfl_xor(ss, 4);
        const float rstd = rsqrtf(ss * (1.f / 64.f) + EPS);
        const u32x4 gw = *(const u32x4*)(PJ + tok * NPROJ + P_DG + hc * 8); const f32x4 w0 = *(const f32x4*)(nw + (hc & 7) * 8), w1 = *(const f32x4*)(nw + (hc & 7) * 8 + 4);
        float o[8];
#pragma unroll
        for (int e = 0; e < 8; ++e) { const float z = bf2f(e & 1 ? gw[e >> 1] >> 16 : gw[e >> 1] & 0xffffu); const float wv = e < 4 ? w0[e] : w1[e - 4]; o[e] = v[e] * rstd * wv * (z / (1.f + __expf(-z))); }
        u32x4 w; w.x = pk2(o[0], o[1]); w.y = pk2(o[2], o[3]); w.z = pk2(o[4], o[5]); w.w = pk2(o[6], o[7]);
        *(u32x4*)(OC + tok * D + 512 + hc * 8) = w;
    }
}
__global__ void __launch_bounds__(NTHR, 2) mk_fwd(const Args args) {
    extern __shared__ __attribute__((aligned(16))) unsigned char lds_raw[];
    Frame F;
    F.lds = (LAS unsigned char*)lds_raw; F.ws = args.ws;
    F.tid = threadIdx.x; F.lane = F.tid & 63; F.wave = __builtin_amdgcn_readfirstlane(F.tid >> 6);
    F.G = gridDim.x; { const int bx = blockIdx.x; F.vcu = (F.G % 8 == 0) ? (bx % 8) * (F.G / 8) + bx / 8 : bx; }
    volatile LAS unsigned* MISC = (volatile LAS unsigned*)(F.lds + MISC_OFF);
    volatile LAS int* mts = (volatile LAS int*)(F.lds + MISC_OFF + 256);
    for (int u = F.tid; u < 1024; u += NTHR) MISC[u] = 0u;
    __syncthreads();
    const int lo = args.ph_lo, hi = args.ph_hi;
    unsigned* ctl = (unsigned*)(args.ws + WS_CTL);
    XcdBarrier bar; bar.bar = ctl + CW_BAR; bar.x = 0; bar.st = MISC + 8;
    if (hi - lo > 1) bar = xcd_barrier_post(ctl + CW_BAR, MISC + 8);
    unsigned char* ws = args.ws;
#define IN(k) (frame_refresh(F), (lo <= (k) && (k) < hi))
#define SEAM(k) do { if (IN(k) && IN((k) + 1)) xcd_barrier(bar, F.wave); } while (0)
#if !defined(PH_MASK) || (PH_MASK & (1 << 0))
    if (IN(0)) { p0_prologue(F, args); } SEAM(0);
#endif
#if !defined(PH_MASK) || (PH_MASK & (1 << 1))
    if (IN(1)) { norm_skinny<0, 2>(F, args, 0, NT / 64, true); frame_refresh(F); norm_skinny<0, 8>(F, args, NT, NC / 8, false); } SEAM(1);
#endif
#if !defined(PH_MASK) || (PH_MASK & (1 << 2))
    if (IN(2)) { ProbProj P{(const bf16*)(ws + WS_H), (const bf16*)(ws + WS_WIN), (bf16*)(ws + WS_PROJ), F.G, (int)blockIdx.x}; gemm_phase(F.lds, P, F.wave); } SEAM(2);
#endif
#if !defined(PH_MASK) || (PH_MASK & (1 << 3))
    if (IN(3)) { dn_prep(F, args); } SEAM(3);
#endif
#if !defined(PH_MASK) || (PH_MASK & (1 << 4))
    if (IN(4)) { const int nscan = F.G >= 128 ? 64 : 0;
        if (args.p4mode == 1) dn_scan(F, args, (int)blockIdx.x, F.G, true);
#ifndef DBG_NO_NA
        else if (args.p4mode == 2) na_phase(F, args, (int)blockIdx.x, F.G);
        else if (nscan == 0) { dn_scan(F, args, (int)blockIdx.x, F.G, true); na_phase(F, args, (int)blockIdx.x, F.G); }
#endif
        else if ((int)blockIdx.x < nscan) dn_scan(F, args, (int)blockIdx.x, nscan, false);
#ifndef DBG_NO_NA
        else { na_phase(F, args, (int)blockIdx.x - nscan, F.G - nscan); frame_refresh(F); dn_out_items(F, args, (int)blockIdx.x - nscan, F.G - nscan); }
#endif
        } SEAM(4);
#endif
#if !defined(PH_MASK) || (PH_MASK & (1 << 5))
    (void)0;
#endif
#if !defined(PH_MASK) || (PH_MASK & (1 << 6))
    if (IN(6)) { ProbE1 P{(const bf16*)(ws + WS_OCAT), (const bf16*)(ws + WS_WBR), (const bf16*)(ws + WS_PROJ), (bf16*)(ws + WS_Y1), F.G, (int)blockIdx.x}; gemm_phase(F.lds, P, F.wave); } SEAM(6);
#endif
#if !defined(PH_MASK) || (PH_MASK & (1 << 7))
    if (IN(7)) { ProbE2 P{(const bf16*)(ws + WS_Y1), (const bf16*)(ws + WS_WOUT), args.in[0], (const float*)(ws + WS_MOD), args.out, F.G, (int)blockIdx.x}; gemm_phase(F.lds, P, F.wave); } SEAM(7);
#endif
#if !defined(PH_MASK) || (PH_MASK & (1 << 8))
    if (IN(8)) { norm_skinny<1, 2>(F, args, 0, NT / 64, true); } SEAM(8);
#endif
#if !defined(PH_MASK) || (PH_MASK & (1 << 9))
    if (IN(9)) { moe_tile_starts(F, mts);
        ProbMoe1 P{(const unsigned char*)(ws + WS_H), (const unsigned char*)(ws + WS_W1), (unsigned char*)(ws + WS_ACT), args.in[20], (const int*)(ws + WS_TOKL), (const unsigned*)(ws + WS_CTL) + CW_CNT, mts, F.G, (int)blockIdx.x, __builtin_amdgcn_readfirstlane(mts[E])}; gemm_phase(F.lds, P, F.wave); } SEAM(9);
#endif
#if !defined(PH_MASK) || (PH_MASK & (1 << 10))
    if (IN(10)) { moe_tile_starts(F, mts);
        ProbMoe2 P{(const unsigned char*)(ws + WS_ACT), (const unsigned char*)(ws + WS_W2), (unsigned char*)(ws + WS_Y2), args.in[22], (const float*)(ws + WS_GATEL), (const unsigned*)(ws + WS_CTL) + CW_CNT, mts, F.G, (int)blockIdx.x, __builtin_amdgcn_readfirstlane(mts[E])}; gemm_phase(F.lds, P, F.wave); } SEAM(10);
#endif
#if !defined(PH_MASK) || (PH_MASK & (1 << 11))
    if (IN(11)) { moe_tile_starts(F, mts); final_phase(F, args, mts); }
#endif
#undef IN
#undef SEAM
}
}

extern "C" void kernel_launch(void* const* d_in, const int* in_sizes, int n_in, void* d_out, int out_size, void* d_ws, size_t ws_size, hipStream_t stream) {
    static int grid = 0;
    if (grid == 0) {
        int dev = 0, cus = 0; (void)hipGetDevice(&dev); (void)hipDeviceGetAttribute(&cus, hipDeviceAttributeMultiprocessorCount, dev);
        (void)hipFuncSetAttribute((const void*)mk::mk_fwd, hipFuncAttributeMaxDynamicSharedMemorySize, mk::LDS_BYTES);
        grid = cus > 0 ? cus : 256;
        if (ws_size < mk::WS_END || n_in != 24) { fprintf(stderr, "kernel_launch: ws too small (%zu) or bad n_in %d\n", ws_size, n_in); grid = -1; }
    }
    if (grid < 0) return;
    (void)hipMemsetAsync((char*)d_ws + mk::WS_CTL, 0, mk::CTL_BYTES, stream);
    mk::Args a{};
    for (int i = 0; i < 24; ++i) a.in[i] = (const float*)d_in[i];
    a.out = (float*)d_out; a.ws = (unsigned char*)d_ws;
    a.ph_lo = 0; a.ph_hi = 12; hipLaunchKernelGGL(mk::mk_fwd, dim3(grid), dim3(mk::NTHR), mk::LDS_BYTES, stream, a);
}
```

```cpp
#include <hip/hip_runtime.h>
#include <cstdio>
#include <cstdint>
namespace mk {
#define LAS __attribute__((address_space(3)))
#define GAS __attribute__((address_space(1)))
typedef unsigned short bf16;
typedef short bf16x8 __attribute__((ext_vector_type(8)));
typedef float f32x4 __attribute__((ext_vector_type(4)));
typedef float f32x2 __attribute__((ext_vector_type(2)));
typedef unsigned u32x4 __attribute__((ext_vector_type(4)));
typedef unsigned u32x2 __attribute__((ext_vector_type(2)));

constexpr int D = 1024, NB = 8, T = 2048, LC = 256, NT = NB * T, NC = NB * LC, NR = NT + NC, H = 8;
constexpr int NPROJ = 5632;
constexpr int P_NAQ = 0, P_NAK = 512, P_NAV = 1024, P_DQ = 1536, P_DK = 2048, P_DV = 2560, P_DG = 3072, P_GA = 3584, P_GB = 4608;
constexpr int E = 32, FF = 1024, DIN = 5664;
constexpr float EPS = 1e-6f;
constexpr int NWAVES = 8, NTHR = 512;
constexpr int MAXMT = 288;

constexpr size_t MiB = 1u << 20;
constexpr size_t WS_CTL = 0, CTL_BYTES = 40960;
constexpr size_t WS_MOD = 1 * MiB, WS_ROPE = 2 * MiB, WS_W32 = 3 * MiB, WS_BETA = 4 * MiB, WS_G = 6 * MiB;
constexpr size_t WS_TOKL = 8 * MiB, WS_GATEL = 10 * MiB, WS_ASG = 12 * MiB;
constexpr size_t WS_WIN = 16 * MiB, WS_WBR = 28 * MiB, WS_WOUT = 30 * MiB, WS_W1 = 32 * MiB, WS_W2 = 160 * MiB;
constexpr size_t WS_H = 224 * MiB, WS_PROJ = 260 * MiB, WS_ACT = 260 * MiB, WS_DNOP = 458 * MiB, WS_Y2 = 458 * MiB;
constexpr size_t WS_HG8 = 96 * MiB, WS_WG8 = 120 * MiB;
constexpr int PJ_PITCH = 1152;
constexpr int PJ_NCT = 0;
constexpr size_t WS_OF = 896 * MiB, WS_OB = 928 * MiB, WS_OCAT = 960 * MiB, WS_Y1 = 992 * MiB, WS_END = 1024 * MiB;
constexpr int CW_CNT = 64, CW_BAR = 4096;

__device__ __forceinline__ float siluf(float x) { return x * __builtin_amdgcn_rcpf(1.f + __expf(-x)); }
__device__ __forceinline__ float sigmf(float x) { return __builtin_amdgcn_rcpf(1.f + __expf(-x)); }
__device__ __forceinline__ unsigned f2bf(float f) { unsigned u = __builtin_bit_cast(unsigned, f); return (u + 0x7fffu + ((u >> 16) & 1u)) >> 16; }
__device__ __forceinline__ float bf2f(unsigned b) { return __builtin_bit_cast(float, b << 16); }

__device__ __forceinline__ unsigned pk2(float lo, float hi);
typedef __bf16 bf16x2_t __attribute__((ext_vector_type(2)));
__device__ __forceinline__ unsigned cvt_pk_bf16(float lo, float hi) { const f32x2 v = {lo, hi}; const bf16x2_t b = __builtin_convertvector(v, bf16x2_t); return __builtin_bit_cast(unsigned, b); }
__device__ __forceinline__ unsigned pk2(float lo, float hi) { return cvt_pk_bf16(lo, hi); }
#define LDS_WAIT() asm volatile("s_waitcnt lgkmcnt(0)" ::: "memory")
#define LDS_BARRIER() do { asm volatile("s_waitcnt lgkmcnt(0)" ::: "memory"); __builtin_amdgcn_s_barrier(); asm volatile("" ::: "memory"); } while (0)
#define VM_WAIT() asm volatile("s_waitcnt vmcnt(0)" ::: "memory")

#define XB_TMO      128
#define XB_XCNT(j)  (256  + 64 * (j))
#define XB_XSUB(j)  (1280 + 64 * (j))
#define XB_XGEN(j)  (2304 + 64 * (j))
#define XB_TOP      3328
#define XB_TOPGEN   3392
#define XCD_BAR_WORDS 3456
#define XB_SPIN_CAP (1u << 18)
__device__ __forceinline__ unsigned xb_ld(unsigned* p)              { return __hip_atomic_load(p, __ATOMIC_RELAXED, __HIP_MEMORY_SCOPE_AGENT); }
__device__ __forceinline__ unsigned xb_add(unsigned* p, unsigned v) { return __hip_atomic_fetch_add(p, v, __ATOMIC_RELAXED, __HIP_MEMORY_SCOPE_AGENT); }
__device__ __forceinline__ unsigned xb_xcc_id() { return (unsigned)__builtin_amdgcn_s_getreg((3 << 11) | 20) & 0xFu; }
#define XB_SPIN(cond, bar) do { unsigned _sp = 0; while (cond) { __builtin_amdgcn_s_sleep(1); \
    if ((++_sp & 255u) == 0u) { if (xb_ld(&(bar)[XB_TMO])) break; if (_sp > XB_SPIN_CAP) { atomicAdd(&(bar)[XB_TMO], 1u); break; } } } } while (0)
struct XcdBarrier { unsigned* bar; unsigned x; volatile LAS unsigned* st; };
__device__ __forceinline__ XcdBarrier xcd_barrier_post(unsigned* bar, volatile LAS unsigned* st) {
    XcdBarrier b; b.bar = bar; b.x = xb_xcc_id(); b.st = st;
    if (threadIdx.x == 0) (void)xb_add(&bar[XB_XCNT(b.x)], 1u);
    return b;
}
__device__ __forceinline__ void xcd_barrier_complete(unsigned* bar, unsigned x, unsigned& nloc, unsigned& nx) {
    const unsigned G = gridDim.x * gridDim.y * gridDim.z;
    unsigned sum, cnt, mine, sp = 0u;
    for (;;) {
        sum = 0u; cnt = 0u; mine = 0u;
#pragma unroll
        for (unsigned j = 0; j < 16; ++j) { const unsigned c = xb_ld(&bar[XB_XCNT(j)]); sum += c; cnt += (c > 0u) ? 1u : 0u; mine = (j == x) ? c : mine; }
        if (sum == G) break;
        __builtin_amdgcn_s_sleep(1);
        if ((++sp & 255u) == 0u) { if (xb_ld(&bar[XB_TMO])) break; if (sp > XB_SPIN_CAP) { atomicAdd(&bar[XB_TMO], 1u); break; } }
    }
    nloc = mine > 0u ? mine : 1u; nx = cnt > 0u ? cnt : 1u;
}
__device__ __forceinline__ void xcd_barrier(const XcdBarrier& b, int wave) {
    asm volatile("s_waitcnt vmcnt(0)" ::: "memory");
    __syncthreads();
    int ln_; asm volatile("v_mbcnt_lo_u32_b32 %0, -1, 0\n\tv_mbcnt_hi_u32_b32 %0, -1, %0" : "=v"(ln_));
    if (wave == 0 && ln_ == 0) {
        unsigned* bar = b.bar;
        __builtin_amdgcn_s_waitcnt(0);
        unsigned nloc = b.st[0], nx = b.st[1];
        if (nloc == 0u) { xcd_barrier_complete(bar, b.x, nloc, nx); b.st[0] = nloc; b.st[1] = nx; }
        const unsigned old = xb_add(&bar[XB_XSUB(b.x)], 1u);
        const unsigned gen = old / nloc;
        if (old + 1u == (gen + 1u) * nloc) {
            __builtin_amdgcn_fence(__ATOMIC_RELEASE, "agent");
            asm volatile("s_waitcnt vmcnt(0)" ::: "memory");
            const unsigned og = xb_add(&bar[XB_TOP], 1u);
            const unsigned tg = og / nx;
            if (og + 1u == (tg + 1u) * nx) xb_add(&bar[XB_TOPGEN], 1u);
            else XB_SPIN(xb_ld(&bar[XB_TOPGEN]) == tg, bar);
            __builtin_amdgcn_fence(__ATOMIC_ACQUIRE, "agent");
            xb_add(&bar[XB_XGEN(b.x)], 1u);
            asm volatile("s_waitcnt vmcnt(0)" ::: "memory");
        } else {
            XB_SPIN(xb_ld(&bar[XB_XGEN(b.x)]) == gen, bar);
            __builtin_amdgcn_fence(__ATOMIC_ACQUIRE, "agent");
            asm volatile("s_waitcnt vmcnt(0)" ::: "memory");
        }
    }
    __syncthreads();
}

constexpr int BM = 256, BK = 64, HALF = 128, HTB = HALF * BK * 2, STAGE_BYTES = 8 * HTB;
__host__ __device__ __forceinline__ int lds_byte(int r, int c) { const int st = (r >> 4) * 2 + (c >> 5), rr = r & 15, cc = c & 31, ob = rr * 64 + cc * 2; return st * 1024 + (ob ^ (((ob >> 9) & 1) << 5)); }
__host__ __device__ __forceinline__ void stage_rc(int b, int& R, int& C) { const int st = b / 1024, sb = b % 1024, swz = sb ^ (((sb >> 9) & 1) << 5); R = (st >> 1) * 16 + swz / 64; C = (st & 1) * 32 + (swz % 64) / 2; }
__host__ __device__ __forceinline__ int perm32(int rho) { const int n = rho >> 4, i = rho & 15; return 8 * (i >> 2) + 4 * n + (i & 3); }
typedef int i32x8 __attribute__((ext_vector_type(8)));
typedef int i32x4 __attribute__((ext_vector_type(4)));
__device__ __forceinline__ f32x4 mfma_f8(bf16x8 a0, bf16x8 a1, bf16x8 b0, bf16x8 b1, f32x4 c) {
    const i32x4 a0i = __builtin_bit_cast(i32x4, a0), a1i = __builtin_bit_cast(i32x4, a1), b0i = __builtin_bit_cast(i32x4, b0), b1i = __builtin_bit_cast(i32x4, b1);
    const i32x8 A = __builtin_shufflevector(a0i, a1i, 0, 1, 2, 3, 4, 5, 6, 7), B = __builtin_shufflevector(b0i, b1i, 0, 1, 2, 3, 4, 5, 6, 7);
    return __builtin_amdgcn_mfma_scale_f32_16x16x128_f8f6f4(A, B, c, 0, 0, 0, 0x7f7f7f7f, 0, 0x7f7f7f7f);
}
__device__ __forceinline__ unsigned pk4_fp8(float a, float b, float c, float d) {
    a = fminf(fmaxf(a, -448.f), 448.f); b = fminf(fmaxf(b, -448.f), 448.f); c = fminf(fmaxf(c, -448.f), 448.f); d = fminf(fmaxf(d, -448.f), 448.f);
    int p = __builtin_amdgcn_cvt_pk_fp8_f32(a, b, 0, false); p = __builtin_amdgcn_cvt_pk_fp8_f32(c, d, p, true); return (unsigned)p;
}
struct Unit { int pm, pn, e, rb; };

template <class P>
__device__ __forceinline__ void gemm_phase(LAS unsigned char* lds, const P& S, int wave_id) {
    const int wid = wave_id, wr = wid >> 2, wc = wid & 3;
#define PG8_LANE() ({ int _ln; asm volatile("v_mbcnt_lo_u32_b32 %0, -1, 0\n\tv_mbcnt_hi_u32_b32 %0, -1, %0" : "=v"(_ln)); _ln; })
#define tid (wid * 64 + PG8_LANE())
    constexpr int RB = P::ROWB, nt = P::KB / (BK * 2);
    unsigned voffB;
    { int R, C; stage_rc(tid * 16, R, C); const int Rb = P::PERM ? ((R & ~31) + perm32(R & 31)) : R; const int Rs = P::ILV ? (2 * (Rb & ~7) + (Rb & 7)) : Rb; voffB = (unsigned)(Rs * RB + C * 2); }
    constexpr int BPS = P::ILV ? 128 : 64;
    const size_t bhstep = P::ILV ? (size_t)8 * RB : (size_t)HALF * RB;
#define PG8_STAGEB(bufoff, gbase) do { _Pragma("unroll") for (int _i = 0; _i < 2; ++_i) { unsigned _vo = voffB; asm volatile("" : "+v"(_vo)); \
        __builtin_amdgcn_global_load_lds((const unsigned*)((const char*)(gbase) + (size_t)_i * BPS * RB + _vo), (LAS unsigned*)(lds + (bufoff) + ldsw + _i * 8192), 16, 0, 0); } } while (0)
#define PG8_STAGE1(bufoff, gbase, voff1) do { _Pragma("unroll") for (int _i = 0; _i < 2; ++_i) { unsigned _vo = (voff1); asm volatile("" : "+v"(_vo)); \
        __builtin_amdgcn_global_load_lds((const unsigned*)((const char*)(gbase) + (size_t)_i * 64 * RB + _vo), (LAS unsigned*)(lds + (bufoff) + ldsw + _i * 8192), 16, 0, 0); } } while (0)
#define PG8_AOFFS(unit, dst) do { const int _t = tid; int sR[2], sC[2]; _Pragma("unroll") for (int _i = 0; _i < 2; ++_i) stage_rc(_t * 16 + _i * 8192, sR[_i], sC[_i]); S.a_offs(unit, sR, sC, dst); } while (0)
    const size_t kstep = (size_t)(BK * 2);
    const size_t hstep = (size_t)HALF * RB;
    const unsigned ldsw = (unsigned)wid * 1024u;
    int aoff, boff; { const int _l = PG8_LANE(), fr = _l & 15, fq = _l >> 4; aoff = lds_byte(wr * 64 + fr, fq * 8); boff = lds_byte(wc * 32 + fr, fq * 8); }
#define PG8_SA(b, h) (((b) * 2 + (h)) * HTB)
#define PG8_SB(b, h) ((4 + (b) * 2 + (h)) * HTB)
#define PG8_STAGE(bufoff, gbase, voff) do { _Pragma("unroll") for (int _i = 0; _i < 2; ++_i) { unsigned _vo = (voff)[_i]; asm volatile("" : "+v"(_vo)); \
        __builtin_amdgcn_global_load_lds((const unsigned*)((const char*)(gbase) + _vo), (LAS unsigned*)(lds + (bufoff) + ldsw + _i * 8192), 16, 0, 0); } } while (0)
#define PG8_LDA(dst, b, h) do { _Pragma("unroll") for (int m = 0; m < 4; ++m) _Pragma("unroll") for (int k = 0; k < 2; ++k) dst[m][k] = *(const LAS bf16x8*)(lds + PG8_SA(b, h) + aoff + m * 2048 + k * 1024); } while (0)
#define PG8_LDB(dst, b, h) do { _Pragma("unroll") for (int n = 0; n < 2; ++n) _Pragma("unroll") for (int k = 0; k < 2; ++k) dst[n][k] = *(const LAS bf16x8*)(lds + PG8_SB(b, h) + boff + n * 2048 + k * 1024); } while (0)
#define PG8_MMA(ai, bj, At, Bt) do { __builtin_amdgcn_s_setprio(1); _Pragma("unroll") for (int m = 0; m < 4; ++m) _Pragma("unroll") for (int n = 0; n < 2; ++n) { \
        if constexpr (P::F8) acc[ai][bj][m][n] = mfma_f8(Bt[n][0], Bt[n][1], At[m][0], At[m][1], acc[ai][bj][m][n]); \
        else { _Pragma("unroll") for (int k = 0; k < 2; ++k) acc[ai][bj][m][n] = __builtin_amdgcn_mfma_f32_16x16x32_bf16(Bt[n][k], At[m][k], acc[ai][bj][m][n], 0, 0, 0); } } __builtin_amdgcn_s_setprio(0); } while (0)
#define PG8_WAIT_V(n) asm volatile("s_waitcnt vmcnt(" #n ")" ::: "memory")
#define PG8_WAIT_L(n) asm volatile("s_waitcnt lgkmcnt(" #n ")" ::: "memory")
#define PG8_BAR __builtin_amdgcn_s_barrier()
#define PG8_SCHED __builtin_amdgcn_sched_barrier(0)
    Unit cur, nxt; int ui = 0;
    if (!S.next(0, cur)) return;
    f32x4 acc[2][2][4][2];
#pragma unroll
    for (int a = 0; a < 2; ++a)
#pragma unroll
        for (int b = 0; b < 2; ++b)
#pragma unroll
            for (int m = 0; m < 4; ++m)
#pragma unroll
                for (int n = 0; n < 2; ++n) acc[a][b][m][n] = (f32x4){0.f, 0.f, 0.f, 0.f};
    bf16x8 At[4][2], B0[2][2], B1[2][2];
    unsigned vA[2][2];
#define stash ((LAS unsigned*)(lds + STAGE_BYTES) + tid * 4)
    if constexpr (P::DENSE) { int R, C; stage_rc(tid * 16, R, C); vA[0][0] = (unsigned)(R * RB + C * 2); vA[0][1] = 0u; vA[1][0] = 0u; vA[1][1] = 0u; }
    else PG8_AOFFS(cur, vA);
#define PG8_STAGE_A(bufoff, base, h) do { if constexpr (P::DENSE) PG8_STAGE1(bufoff, (base) + (h) * hstep, vA[0][0]); else PG8_STAGE(bufoff, base, vA[h]); } while (0)
#define PG8_STAGE_AN(bufoff, base, h) do { if constexpr (P::DENSE) PG8_STAGE1(bufoff, (base) + (h) * hstep, vA[0][0]); else { unsigned _w[2]; \
        { const unsigned _s0 = stash[2 * (h)], _s1 = stash[2 * (h) + 1]; _w[0] = last ? _s0 : vA[h][0]; _w[1] = last ? _s1 : vA[h][1]; } PG8_STAGE(bufoff, base, _w); } } while (0)
    const char* cA = S.a_base(cur); const char* cB = S.b_base(cur);
    PG8_STAGEB(PG8_SB(0, 0), cB); PG8_STAGEB(PG8_SB(0, 1), cB + bhstep); PG8_STAGE_A(PG8_SA(0, 0), cA, 0); PG8_STAGE_A(PG8_SA(0, 1), cA, 1);
    if (wr == 1) PG8_BAR;
    PG8_WAIT_V(2); PG8_BAR;
    PG8_STAGEB(PG8_SB(1, 0), cB + kstep); PG8_STAGE_A(PG8_SA(1, 0), cA + kstep, 0); PG8_STAGEB(PG8_SB(1, 1), cB + bhstep + kstep);
    PG8_WAIT_V(6); PG8_BAR;
    for (;;) {
        const bool has_next = S.next(ui + 1, nxt);
        const char* nA = cA; const char* nB = cB;
        if (has_next) { nA = S.a_base(nxt); nB = S.b_base(nxt); }
        if constexpr (!P::DENSE) { unsigned nv[2][2];
#pragma unroll
            for (int h = 0; h < 2; ++h)
#pragma unroll
                for (int i = 0; i < 2; ++i) nv[h][i] = vA[h][i];
            if (has_next) PG8_AOFFS(nxt, nv);
            stash[0] = nv[0][0]; stash[1] = nv[0][1]; stash[2] = nv[1][0]; stash[3] = nv[1][1]; }
#pragma unroll 1
        for (int t = 0; t < nt; t += 2) {
            const bool last = (t == nt - 2);
            if constexpr (P::HOOK) { if (t == nt / 2) { const int _l = PG8_LANE(); S.hook(acc, cur, wr, wc, _l & 15, _l >> 4); } }
            const char* a1 = cA + (size_t)(t + 1) * kstep;
            const char* a2 = last ? nA : cA + (size_t)(t + 2) * kstep; const char* b2 = last ? nB : cB + (size_t)(t + 2) * kstep;
            const char* a3 = a2 + kstep; const char* b3 = b2 + kstep;
            PG8_LDB(B0, 0, 0); PG8_LDB(B1, 0, 1); PG8_SCHED; PG8_LDA(At, 0, 0); PG8_STAGE_A(PG8_SA(1, 1), a1, 1);
            PG8_WAIT_V(8); PG8_WAIT_L(0); PG8_BAR; PG8_MMA(0, 0, At, B0); PG8_MMA(0, 1, At, B1); PG8_BAR; PG8_SCHED;
            PG8_LDA(At, 0, 1); PG8_STAGEB(PG8_SB(0, 0), b2); PG8_STAGEB(PG8_SB(0, 1), b2 + bhstep); PG8_STAGE_AN(PG8_SA(0, 0), a2, 0);
            PG8_WAIT_V(8); PG8_WAIT_L(0); PG8_BAR; PG8_MMA(1, 0, At, B0); PG8_MMA(1, 1, At, B1); PG8_BAR; PG8_SCHED;
            PG8_LDB(B0, 1, 0); PG8_LDB(B1, 1, 1); PG8_SCHED; PG8_LDA(At, 1, 0); PG8_STAGE_AN(PG8_SA(0, 1), a2, 1);
            PG8_WAIT_V(8); PG8_WAIT_L(0); PG8_BAR; PG8_MMA(0, 0, At, B0); PG8_MMA(0, 1, At, B1); PG8_BAR; PG8_SCHED;
            PG8_LDA(At, 1, 1); PG8_STAGEB(PG8_SB(1, 0), b3); PG8_STAGEB(PG8_SB(1, 1), b3 + bhstep); PG8_STAGE_AN(PG8_SA(1, 0), a3, 0);
            PG8_WAIT_V(8); PG8_WAIT_L(0); PG8_BAR; PG8_MMA(1, 0, At, B0); PG8_MMA(1, 1, At, B1); PG8_BAR; PG8_SCHED;
        }
        if (wr == 0) PG8_BAR;
        { const int _l = PG8_LANE(); S.epi(acc, cur, wr, wc, _l & 15, _l >> 4); }
        if (!has_next) break;
#pragma unroll
        for (int a = 0; a < 2; ++a)
#pragma unroll
            for (int b = 0; b < 2; ++b)
#pragma unroll
                for (int m = 0; m < 4; ++m)
#pragma unroll
                    for (int n = 0; n < 2; ++n) acc[a][b][m][n] = (f32x4){0.f, 0.f, 0.f, 0.f};
        cur = nxt; cA = nA; cB = nB; ++ui;
        if constexpr (!P::DENSE) { vA[0][0] = stash[0]; vA[0][1] = stash[1]; vA[1][0] = stash[2]; vA[1][1] = stash[3]; }
        if (wr == 1) PG8_BAR;
    }
    PG8_WAIT_V(0);
    PG8_BAR;
#undef PG8_AOFFS
#undef tid
#undef PG8_LANE
#undef stash
#undef PG8_STAGE_A
#undef PG8_STAGE1
#undef PG8_STAGEB
#undef PG8_STAGE_AN
#undef PG8_SA
#undef PG8_SB
#undef PG8_STAGE
#undef PG8_LDA
#undef PG8_LDB
#undef PG8_MMA
#undef PG8_WAIT_V
#undef PG8_WAIT_L
#undef PG8_BAR
#undef PG8_SCHED
}
struct Args {
    const float* in[24]; float* out; unsigned char* ws;
    int ph_lo, ph_hi, p4mode, pad;
};
struct Frame {
    LAS unsigned char* lds; unsigned char* ws;
    int tid, lane, wave, vcu, G;
};
__device__ __forceinline__ void frame_refresh(Frame& F) { int l; asm volatile("v_mbcnt_lo_u32_b32 %0, -1, 0\n\tv_mbcnt_hi_u32_b32 %0, -1, %0" : "=v"(l)); F.lane = l; F.tid = F.wave * 64 + l; }
constexpr int RING_BYTES = 131072;
constexpr int MISC_OFF = 147456 - 4096;
constexpr int LDS_BYTES = 147456;

__device__ __forceinline__ float wave_sum(float v) {
#pragma unroll
    for (int o = 1; o < 64; o <<= 1) v += __shfl_xor(v, o);
    return v;
}

__device__ __forceinline__ void p0_transpose_item_f8(const float* src, int N, unsigned char* dst, int dstStride, LAS float* scr, int lane) {
#pragma unroll 8
    for (int i = 0; i < 32; ++i) { const int kk = 2 * i + (lane >> 5); scr[kk * 33 + (lane & 31)] = src[(size_t)kk * N + (lane & 31)]; }
    LDS_WAIT(); asm volatile("" ::: "memory");
    const int c = lane & 7;
#pragma unroll
    for (int j = 0; j < 4; ++j) { const int n = (lane >> 3) + 8 * j; const LAS float* s = scr + (8 * c) * 33 + n;
        float v[8];
#pragma unroll
        for (int q = 0; q < 8; ++q) v[q] = s[q * 33] * 256.f;
        u32x2 o; o.x = pk4_fp8(v[0], v[1], v[2], v[3]); o.y = pk4_fp8(v[4], v[5], v[6], v[7]);
        *(GAS u32x2*)(dst + (size_t)n * dstStride + 8 * c) = o; }
    LDS_WAIT(); asm volatile("" ::: "memory");
}
template <bool HILO>
__device__ __forceinline__ void p0_transpose_item(const float* src, int N, bf16* dst, int dstStride, size_t loOff, LAS float* scr, int lane) {
#pragma unroll 8
    for (int i = 0; i < 32; ++i) { const int kk = 2 * i + (lane >> 5); scr[kk * 33 + (lane & 31)] = src[(size_t)kk * N + (lane & 31)]; }
    LDS_WAIT(); asm volatile("" ::: "memory");
    const int c = lane & 7;
#pragma unroll
    for (int j = 0; j < 4; ++j) { const int n = (lane >> 3) + 8 * j; const LAS float* s = scr + (8 * c) * 33 + n;
        float v[8];
#pragma unroll
        for (int q = 0; q < 8; ++q) v[q] = s[q * 33];
        u32x4 o; o.x = pk2(v[0], v[1]); o.y = pk2(v[2], v[3]); o.z = pk2(v[4], v[5]); o.w = pk2(v[6], v[7]);
        *(GAS u32x4*)(dst + (size_t)n * dstStride + 8 * c) = o;
        if (HILO) { float r[8];
#pragma unroll
            for (int q = 0; q < 8; ++q) r[q] = v[q] - bf2f(f2bf(v[q]));
            u32x4 p; p.x = pk2(r[0], r[1]); p.y = pk2(r[2], r[3]); p.z = pk2(r[4], r[5]); p.w = pk2(r[6], r[7]);
            *(GAS u32x4*)(dst + loOff + (size_t)n * dstStride + 8 * c) = p; } }
    LDS_WAIT(); asm volatile("" ::: "memory");
}
__device__ __forceinline__ void p0_prologue(Frame& F, const Args& A) {
    const float* c = A.in[1]; const float* cctx = A.in[3]; const float* wmod = A.in[4]; const float* bmod = A.in[5];
    const float* win = A.in[7]; const float* wbra = A.in[13]; const float* wbrb = A.in[14]; const float* wout = A.in[15];
    const float* wrt = A.in[17]; const float* w1 = A.in[19]; const float* w2 = A.in[21];
    float* mod = (float*)(F.ws + WS_MOD); float* rope = (float*)(F.ws + WS_ROPE); bf16* w32 = (bf16*)(F.ws + WS_W32);
    bf16* WinT = (bf16*)(F.ws + WS_WIN); bf16* WbrT = (bf16*)(F.ws + WS_WBR); bf16* WoutT = (bf16*)(F.ws + WS_WOUT); bf16* W1T = (bf16*)(F.ws + WS_W1); bf16* W2T = (bf16*)(F.ws + WS_W2);
    for (int idx = blockIdx.x * NTHR + F.tid; idx < T * 32; idx += F.G * NTHR) {
        const int t = idx >> 5, i = idx & 31; const float pos = (i < 16) ? (float)(t >> 6) : (float)(t & 63);
        const float fr = powf(10000.f, -(float)(i & 15) / 16.f); float sn, cs; sincosf(pos * fr, &sn, &cs);
        rope[2 * idx] = cs; rope[2 * idx + 1] = sn; }
    {
        LAS float* sc = (LAS float*)(F.lds + 73728);
        LAS float* part = (LAS float*)(F.lds + 73728 + 36864);
        if ((int)blockIdx.x < 192) {
            for (int u = F.tid; u < 9 * D; u += NTHR) { const int r = u >> 10, k = u & 1023; const float v = r < 8 ? c[r * D + k] : cctx[k]; sc[u] = v / (1.f + expf(-v)); }
            __syncthreads();
            for (int item = blockIdx.x; item < 192; item += F.G) {
                const int n0 = item * 32, col = F.lane & 31, kp = F.lane >> 5;
                float a[9];
#pragma unroll
                for (int r = 0; r < 9; ++r) a[r] = 0.f;
#pragma unroll 16
                for (int i = 0; i < 64; ++i) { const int k = F.wave * 128 + 2 * i + kp; const float wv = __builtin_nontemporal_load(wmod + (size_t)k * 6 * D + n0 + col);
#pragma unroll
                    for (int r = 0; r < 9; ++r) a[r] += sc[r * D + k] * wv; }
#pragma unroll
                for (int r = 0; r < 9; ++r) part[((F.wave * 2 + kp) * 9 + r) * 32 + col] = a[r];
                __syncthreads();
                if (F.tid < 288) { const int r = F.tid >> 5, cc = F.tid & 31; float s = 0.f;
#pragma unroll
                    for (int p = 0; p < 16; ++p) s += part[(p * 9 + r) * 32 + cc];
                    mod[r * 6 * D + n0 + cc] = s + bmod[n0 + cc]; }
                __syncthreads();
            }
        }
    }
    LAS float* scr = (LAS float*)(F.lds + F.wave * 9216);
    const int gw = F.vcu * NWAVES + F.wave, NGW = F.G * NWAVES;
    constexpr int I_IN = 16 * 177, I_BR = 8 * 32, I_OUT = 16 * 32, I_W1 = E * 16 * 64, I_W2 = E * 16 * 32, I_RT = 16;
    constexpr int NITEMS = I_IN + 2 * I_BR + I_OUT + I_W1 + I_W2 + I_RT;
    struct Desc { const float* src; unsigned char* dst; int N, dstStride, kind; bool valid; };
    auto describe = [&](int it) -> Desc { Desc d; d.valid = it < NITEMS; d.src = win; d.dst = (unsigned char*)WinT; d.N = DIN; d.dstStride = D * 2; d.kind = 0; if (!d.valid) return d;
        int r = it;
        if (r < I_IN) { const int kb = r / 177, nb = r % 177, n0 = nb * 32, k0 = kb * 64; d.src = win + (size_t)k0 * DIN + n0; d.N = DIN; d.dstStride = D * 2;
            if (n0 == 3584) { d.dst = (unsigned char*)(w32 + k0); d.kind = 1; }
            else { const int pc = n0 < 3584 ? n0 : n0 - 32;
                if (pc >= PJ_NCT * 256) { d.dst = F.ws + WS_WG8 + (size_t)pc * PJ_PITCH + k0; d.dstStride = PJ_PITCH; d.kind = 2; }
                else { d.dst = (unsigned char*)(WinT + (size_t)pc * D + k0); d.kind = 0; } } return d; } r -= I_IN;
        if (r < I_BR) { const int kb = r / 32, nb = r % 32; d.src = wbra + (size_t)(kb * 64) * D + nb * 32; d.N = D; d.dst = (unsigned char*)WbrT + (size_t)(nb * 32) * D + kb * 64; d.dstStride = D; d.kind = 2; return d; } r -= I_BR;
        if (r < I_BR) { const int kb = r / 32, nb = r % 32; d.src = wbrb + (size_t)(kb * 64) * D + nb * 32; d.N = D; d.dst = (unsigned char*)WbrT + (size_t)(nb * 32) * D + 512 + kb * 64; d.dstStride = D; d.kind = 2; return d; } r -= I_BR;
        if (r < I_OUT) { const int kb = r / 32, nb = r % 32; d.src = wout + (size_t)(kb * 64) * D + nb * 32; d.N = D; d.dst = (unsigned char*)WoutT + (size_t)(nb * 32) * D + kb * 64; d.dstStride = D; d.kind = 2; return d; } r -= I_OUT;
        if (r < I_W1) { const int e = r / 1024, q = r % 1024, kb = q / 64, nb = q % 64, n0 = nb * 32;
            const int drow = n0 < FF ? (n0 / 128) * 256 + (n0 % 128) : ((n0 - FF) / 128) * 256 + 128 + ((n0 - FF) % 128);
            d.src = w1 + ((size_t)e * D + kb * 64) * (2 * FF) + n0; d.N = 2 * FF; d.dst = (unsigned char*)W1T + ((size_t)e * 2 * FF + drow) * D + kb * 64; d.dstStride = D; d.kind = 2; return d; } r -= I_W1;
        if (r < I_W2) { const int e = r / 512, q = r % 512, kb = q / 32, nb = q % 32;
            d.src = w2 + ((size_t)e * FF + kb * 64) * D + nb * 32; d.N = D; d.dst = (unsigned char*)W2T + ((size_t)e * D + nb * 32) * FF + kb * 64; d.dstStride = FF; d.kind = 2; return d; } r -= I_W2;
        { const int kb = r; d.src = wrt + (size_t)(kb * 64) * E; d.N = E; d.dst = (unsigned char*)(w32 + 2 * 32 * D + kb * 64); d.dstStride = D * 2; d.kind = 1; return d; } };
    const int ln = F.lane;
#define P0_LOADS(reg, dsc) do { if ((dsc).valid) { _Pragma("unroll") for (int _i = 0; _i < 32; ++_i) reg[_i] = __builtin_nontemporal_load((dsc).src + (size_t)(2 * _i + (ln >> 5)) * (dsc).N + (ln & 31)); } } while (0)
#define P0_FINISH(reg, dsc) do { _Pragma("unroll") for (int _i = 0; _i < 32; ++_i) scr[(2 * _i + (ln >> 5)) * 33 + (ln & 31)] = reg[_i]; LDS_WAIT(); asm volatile("" ::: "memory"); } while (0)
#define P0_STORE(dsc) do { const int _c = ln & 7; _Pragma("unroll") for (int _j = 0; _j < 4; ++_j) { const int _n = (ln >> 3) + 8 * _j; const LAS float* _s = scr + (8 * _c) * 33 + _n; float _v[8]; \
            _Pragma("unroll") for (int _q = 0; _q < 8; ++_q) _v[_q] = _s[_q * 33]; \
            if ((dsc).kind == 2) { u32x2 _o; _o.x = pk4_fp8(_v[0] * 256.f, _v[1] * 256.f, _v[2] * 256.f, _v[3] * 256.f); _o.y = pk4_fp8(_v[4] * 256.f, _v[5] * 256.f, _v[6] * 256.f, _v[7] * 256.f); \
                *(GAS u32x2*)((dsc).dst + (size_t)_n * (dsc).dstStride + 8 * _c) = _o; } \
            else { u32x4 _o; _o.x = pk2(_v[0], _v[1]); _o.y = pk2(_v[2], _v[3]); _o.z = pk2(_v[4], _v[5]); _o.w = pk2(_v[6], _v[7]); *(GAS u32x4*)((dsc).dst + (size_t)_n * (dsc).dstStride + 16 * _c) = _o; \
                if ((dsc).kind == 1) { float _r[8]; _Pragma("unroll") for (int _q = 0; _q < 8; ++_q) _r[_q] = _v[_q] - bf2f(f2bf(_v[_q])); \
                    u32x4 _p; _p.x = pk2(_r[0], _r[1]); _p.y = pk2(_r[2], _r[3]); _p.z = pk2(_r[4], _r[5]); _p.w = pk2(_r[6], _r[7]); *(GAS u32x4*)((dsc).dst + (size_t)(32 + _n) * (dsc).dstStride + 16 * _c) = _p; } } } \
        LDS_WAIT(); asm volatile("" ::: "memory"); } while (0)
    float ldA[32], ldB[32];
#pragma unroll
    for (int i = 0; i < 32; ++i) { ldA[i] = 0.f; ldB[i] = 0.f; }
    Desc d0 = describe(gw), d1 = describe(gw + NGW);
    P0_LOADS(ldA, d0); P0_LOADS(ldB, d1);
    for (int it = gw; it < NITEMS; it += 2 * NGW) {
        P0_FINISH(ldA, d0); const Desc d2 = describe(it + 2 * NGW); P0_LOADS(ldA, d2); P0_STORE(d0);
        if (d1.valid) { P0_FINISH(ldB, d1); const Desc d3 = describe(it + 3 * NGW); P0_LOADS(ldB, d3); P0_STORE(d1); d1 = d3; }
        d0 = d2;
    }
#undef P0_LOADS
#undef P0_FINISH
#undef P0_STORE
}

constexpr int NS_W = 0, NS_WS = 1032, NS_A = 66048, NS_SH = 70144, NS_PART = 74240, NS_SS = 91136, NS_LC = 91648;
template <int MODE, int NK>
__device__ __forceinline__ void norm_skinny(Frame& F, const Args& A, int row_base, int nitems, bool stage) {
    constexpr int NG = 8 / NK, RPI = (NK == 2) ? 64 : 8, RS = (NK == 2) ? 64 : 16, KW = D / NK, NS = KW / 32;
    const int lane = F.lane, tid = F.tid, li = lane & 15, kq = lane >> 4;
    const bf16* whi = (const bf16*)(F.ws + WS_W32) + (MODE == 0 ? 0 : 2 * 32 * D);
    const float* mod = (const float*)(F.ws + WS_MOD);
    const float* nw = A.in[MODE == 0 ? 6 : 16];
    bf16* Hout = (bf16*)(F.ws + WS_H);
    LAS bf16* Wb = (LAS bf16*)(F.lds + NS_W); LAS float* av = (LAS float*)(F.lds + NS_A); LAS float* shv = (LAS float*)(F.lds + NS_SH);
    LAS float* part = (LAS float*)(F.lds + NS_PART); LAS float* ssp = (LAS float*)(F.lds + NS_SS); LAS unsigned* lcnt = (LAS unsigned*)(F.lds + NS_LC); LAS unsigned* lbase = lcnt + 32;
    if (stage && (int)blockIdx.x < nitems) {
#pragma unroll
        for (int i = 0; i < 8; ++i) { const int id = tid + NTHR * i, n = id >> 7, c = id & 127; *(LAS u32x4*)(Wb + n * NS_WS + c * 8) = *(const u32x4*)(whi + (size_t)n * D + c * 8); }
    }
    const int grp = F.wave % NG, kh = F.wave / NG;
    int cur_mr = -1;
    for (int item = blockIdx.x; item < nitems; item += F.G) {
        const int r0 = row_base + item * RPI; const int mr = (MODE == 0 && r0 >= NT) ? 8 : r0 / T;
        __syncthreads();
        if (mr != cur_mr) { cur_mr = mr; const float* sh = mod + mr * 6 * D + (MODE == 0 ? 0 : 3 * D); const float* sc = sh + D;
#pragma unroll
            for (int i = 0; i < 2; ++i) { const int k = tid + NTHR * i; av[k] = nw[k] * (1.f + sc[k]); shv[k] = sh[k]; } }
        if (MODE == 1 && tid < 32) lcnt[tid] = 0u;
        const int row = r0 + (NK == 2 ? 16 * grp + li : (li & 7));
        const float* xr = (MODE == 0) ? ((row < NT) ? A.in[0] + (size_t)row * D : A.in[2] + (size_t)(row - NT) * D) + KW * kh + 8 * kq : nullptr;
        const bf16* xb = (const bf16*)(F.ws + WS_OF) + (size_t)row * D + KW * kh + 8 * kq;
        f32x4 xv[MODE == 0 ? NS : 1][2]; u32x4 xp[MODE == 1 ? NS : 1]; float ss = 0.f;
#define NSX(s, e) (MODE == 0 ? xv[MODE == 0 ? (s) : 0][(e) >> 2][(e) & 3] : (((e) & 1) ? __builtin_bit_cast(float, xp[MODE == 1 ? (s) : 0][(e) >> 1] & 0xffff0000u) : __builtin_bit_cast(float, xp[MODE == 1 ? (s) : 0][(e) >> 1] << 16)))
#pragma unroll
        for (int s = 0; s < NS; ++s) { if (MODE == 0) { xv[MODE == 0 ? s : 0][0] = __builtin_nontemporal_load((const f32x4*)(xr + 32 * s)); xv[MODE == 0 ? s : 0][1] = __builtin_nontemporal_load((const f32x4*)(xr + 32 * s + 4)); }
            else xp[MODE == 1 ? s : 0] = __builtin_nontemporal_load((const u32x4*)(xb + 32 * s)); }
#pragma unroll
        for (int s = 0; s < NS; ++s) { float e8[8];
#pragma unroll
            for (int e = 0; e < 8; ++e) e8[e] = NSX(s, e);
            ss += ((e8[0] * e8[0] + e8[1] * e8[1]) + (e8[2] * e8[2] + e8[3] * e8[3])) + ((e8[4] * e8[4] + e8[5] * e8[5]) + (e8[6] * e8[6] + e8[7] * e8[7])); }
        if (MODE == 1) {
#pragma unroll
            for (int s = 0; s < NS; ++s) asm volatile("" : "+v"(xp[MODE == 1 ? s : 0])); }
        ss += __shfl_xor(ss, 16); ss += __shfl_xor(ss, 32);
        if (kq == 0) ssp[kh * RS + 16 * grp + li] = ss;
        __syncthreads();
        float sst = 0.f;
#pragma unroll
        for (int p = 0; p < NK; ++p) sst += ssp[p * RS + 16 * grp + li];
        const float rstd = rsqrtf(sst * (1.f / D) + EPS);
        f32x4 acc[2] = {(f32x4){0.f, 0.f, 0.f, 0.f}, (f32x4){0.f, 0.f, 0.f, 0.f}};
        bf16* hrow = Hout + (size_t)row * D + KW * kh + 8 * kq;
#pragma unroll
        for (int s = 0; s < NS; ++s) {
            const int k0 = KW * kh + 32 * s + 8 * kq;
            float hv[8];
#pragma unroll
            for (int q = 0; q < 2; ++q) { const f32x4 a4 = *(const LAS f32x4*)(av + k0 + 4 * q), s4 = *(const LAS f32x4*)(shv + k0 + 4 * q);
#pragma unroll
                for (int j = 0; j < 4; ++j) hv[4 * q + j] = NSX(s, 4 * q + j) * rstd * a4[j] + s4[j]; }
            u32x4 hp, lp;
            hp.x = cvt_pk_bf16(hv[0], hv[1]); hp.y = cvt_pk_bf16(hv[2], hv[3]); hp.z = cvt_pk_bf16(hv[4], hv[5]); hp.w = cvt_pk_bf16(hv[6], hv[7]);
            lp.x = cvt_pk_bf16(hv[0] - bf2f(hp.x & 0xffffu), hv[1] - bf2f(hp.x >> 16)); lp.y = cvt_pk_bf16(hv[2] - bf2f(hp.y & 0xffffu), hv[3] - bf2f(hp.y >> 16));
            lp.z = cvt_pk_bf16(hv[4] - bf2f(hp.z & 0xffffu), hv[5] - bf2f(hp.z >> 16)); lp.w = cvt_pk_bf16(hv[6] - bf2f(hp.w & 0xffffu), hv[7] - bf2f(hp.w >> 16));
            if (MODE == 0) { if (PJ_NCT > 0) *(GAS u32x4*)(hrow + 32 * s) = hp;
                { u32x2 q8; q8.x = pk4_fp8(hv[0] * 16.f, hv[1] * 16.f, hv[2] * 16.f, hv[3] * 16.f); q8.y = pk4_fp8(hv[4] * 16.f, hv[5] * 16.f, hv[6] * 16.f, hv[7] * 16.f);
                    *(GAS u32x2*)(F.ws + WS_HG8 + (size_t)row * PJ_PITCH + KW * kh + 8 * kq + 32 * s) = q8; } }
            else { u32x2 q8; q8.x = pk4_fp8(hv[0] * 16.f, hv[1] * 16.f, hv[2] * 16.f, hv[3] * 16.f); q8.y = pk4_fp8(hv[4] * 16.f, hv[5] * 16.f, hv[6] * 16.f, hv[7] * 16.f);
                *(GAS u32x2*)((unsigned char*)Hout + (size_t)row * D + KW * kh + 8 * kq + 32 * s) = q8; }
            const bf16x8 Ahi = __builtin_bit_cast(bf16x8, hp), Alo = __builtin_bit_cast(bf16x8, lp);
#pragma unroll
            for (int n = 0; n < 2; ++n) { const bf16x8 Bf = *(const LAS bf16x8*)(Wb + (16 * n + li) * NS_WS + k0);
                acc[n] = __builtin_amdgcn_mfma_f32_16x16x32_bf16(Ahi, Bf, acc[n], 0, 0, 0);
                acc[n] = __builtin_amdgcn_mfma_f32_16x16x32_bf16(Alo, Bf, acc[n], 0, 0, 0); }
        }
#pragma unroll
        for (int n = 0; n < 2; ++n)
#pragma unroll
            for (int r = 0; r < 4; ++r) part[(kh * RS + 16 * grp + 4 * kq + r) * 33 + 16 * n + li] = acc[n][r];
        __syncthreads();
        if (MODE == 0) {
            float* beta = (float*)(F.ws + WS_BETA); float* gg = (float*)(F.ws + WS_G);
            const int rl = tid >> 3, j0 = (tid & 7) * 2;
#pragma unroll
            for (int jj = 0; jj < 2; ++jj) { const int j = j0 + jj; if (rl >= RPI) break; float zb = 0.f, za = 0.f;
#pragma unroll
                for (int p = 0; p < NK; ++p) { zb += part[(p * RS + rl) * 33 + j]; za += part[(p * RS + rl) * 33 + 16 + j]; }
                const float al = -expf(A.in[10][j]), db = A.in[11][j];
                beta[(size_t)(r0 + rl) * 16 + j] = 1.f / (1.f + expf(-zb));
                const float xx = za + db; const float sp = xx > 20.f ? xx : log1pf(expf(xx)); gg[(size_t)(r0 + rl) * 16 + j] = al * sp; }
        } else {
            unsigned* cnt = (unsigned*)(F.ws + WS_CTL) + CW_CNT; int* tokl = (int*)(F.ws + WS_TOKL); float* gatel = (float*)(F.ws + WS_GATEL); int* asg = (int*)(F.ws + WS_ASG);
            const float* brt = A.in[18];
            int li4[4]; float gv[4]; unsigned lp4[4];
            if (tid < 64) {
                const LAS float* p0 = part + tid * 33; const LAS float* p1 = part + (64 + tid) * 33;
                float lv[4]; unsigned used = 0u;
#pragma unroll
                for (int k = 0; k < 4; ++k) { float best = -3.0e38f; int bi = 0;
                    for (int e = 0; e < E; ++e) { const float v = p0[e] + p1[e] + brt[e]; if (!((used >> e) & 1u) && v > best) { best = v; bi = e; } }
                    used |= 1u << bi; lv[k] = best; li4[k] = bi; }
                float s = 0.f;
#pragma unroll
                for (int k = 0; k < 4; ++k) { gv[k] = expf(lv[k] - lv[0]); s += gv[k]; }
                const float inv = 1.f / s;
#pragma unroll
                for (int k = 0; k < 4; ++k) { gv[k] *= inv; lp4[k] = __hip_atomic_fetch_add(lcnt + li4[k], 1u, __ATOMIC_RELAXED, __HIP_MEMORY_SCOPE_WORKGROUP); }
            }
            __syncthreads();
            if (tid < 32) { const unsigned n = lcnt[tid]; lbase[tid] = n ? xb_add(&cnt[tid * 64], n) : 0u; }
            __syncthreads();
            if (tid < 64) { const int tok = r0 + tid;
#pragma unroll
                for (int k = 0; k < 4; ++k) { const int e = li4[k]; const unsigned pos = lbase[e] + lp4[k];
                    tokl[(size_t)e * NT + pos] = tok; gatel[(size_t)e * NT + pos] = gv[k]; asg[tok * 4 + k] = (e << 16) | (int)pos; } }
        }
    }
}
#undef NSX

template <bool F8S>
__device__ __forceinline__ bool pj_next(int i, int G, int c, Unit& u) {
    constexpr int CT[8] = {2, 3, 4, 5, 8, 9, 10, 11};
    constexpr int NB = (PJ_NCT > 11) ? 8 : (PJ_NCT > 8) ? 4 + (PJ_NCT - 8) : (PJ_NCT > 5) ? 4 : (PJ_NCT > 2) ? PJ_NCT - 2 : 0;
    constexpr int T0 = F8S ? PJ_NCT : 0, NL = F8S ? 22 - PJ_NCT : PJ_NCT, NCX = F8S ? 8 - NB : NB, C0 = F8S ? NB : 0;
    int pm, pn;
    if constexpr (NL + NCX == 0) return false;
    constexpr int NLd = NL > 0 ? NL : 1, NCXd = NCX > 0 ? NCX : 1;
    if (G == 256) { const int x = c & 7, s = F8S ? 31 - (c >> 3) : (c >> 3), q = i * 32 + s;
        if (q >= 8 * NL + NCX) return false;
        if (q < 8 * NL) { pm = x + 8 * (q / NLd); pn = T0 + q % NLd; } else { pm = 64 + x; pn = CT[(C0 + q - 8 * NL) & 7]; } }
    else { const int L = i * G + c; if (L >= 64 * NL + 8 * NCX) return false;
        if (L < 64 * NL) { pm = L / NLd; pn = T0 + L % NLd; } else { const int q = L - 64 * NL; pm = 64 + q / NCXd; pn = CT[(C0 + q % NCXd) & 7]; } }
    u.pm = pm; u.pn = pn; u.e = 0; u.rb = 0; return true;
}
struct ProbProj {
    static constexpr int STAMP_ID = 2;
    static constexpr int K = D, ROWB = 2 * D, KB = 2 * D; static constexpr bool PERM = true, HOOK = false, F8 = false, DENSE = true, ILV = false;
    const bf16* A; const bf16* Bt; bf16* O; int G, c;
    __device__ __forceinline__ bool next(int i, Unit& u) const { return pj_next<false>(i, G, c, u); }
    __device__ __forceinline__ const char* a_base(const Unit& u) const { return (const char*)A + (size_t)u.pm * BM * K * 2; }
    __device__ __forceinline__ void a_offs(const Unit&, const int (&R)[2], const int (&C)[2], unsigned (&v)[2][2]) const {
#pragma unroll
        for (int h = 0; h < 2; ++h)
#pragma unroll
            for (int i = 0; i < 2; ++i) v[h][i] = (unsigned)((h * HALF + R[i]) * K + C[i]) * 2u; }
    __device__ __forceinline__ const char* b_base(const Unit& u) const { return (const char*)Bt + (size_t)u.pn * BM * K * 2; }
    __device__ __forceinline__ void hook(f32x4 (&)[2][2][4][2], const Unit&, int, int, int, int) const {}
    __device__ __forceinline__ void epi(const f32x4 (&acc)[2][2][4][2], const Unit& u, int wr, int wc, int fr, int fq) const {
        const int row0 = u.pm * BM + wr * 64 + fr, col0 = u.pn * BM + wc * 32 + 8 * fq;
#pragma unroll
        for (int ai = 0; ai < 2; ++ai)
#pragma unroll
            for (int m = 0; m < 4; ++m) { bf16* rowp = O + (size_t)(row0 + ai * HALF + m * 16) * NPROJ + col0;
#pragma unroll
                for (int bj = 0; bj < 2; ++bj) { const f32x4 v0 = acc[ai][bj][m][0], v1 = acc[ai][bj][m][1];
                    u32x4 w; w.x = cvt_pk_bf16(v0[0], v0[1]); w.y = cvt_pk_bf16(v0[2], v0[3]); w.z = cvt_pk_bf16(v1[0], v1[1]); w.w = cvt_pk_bf16(v1[2], v1[3]);
                    *(u32x4*)(rowp + bj * HALF) = w; } }
    }
};
struct ProbProjG8 {
    static constexpr int STAMP_ID = 2;
    static constexpr int K = D, ROWB = PJ_PITCH, KB = D; static constexpr bool PERM = true, HOOK = false, F8 = true, DENSE = true, ILV = false;
    const unsigned char* A; const unsigned char* Bt; bf16* O; int G, c;
    __device__ __forceinline__ bool next(int i, Unit& u) const { return pj_next<true>(i, G, c, u); }
    __device__ __forceinline__ const char* a_base(const Unit& u) const { return (const char*)A + (size_t)u.pm * BM * ROWB; }
    __device__ __forceinline__ void a_offs(const Unit&, const int (&R)[2], const int (&C)[2], unsigned (&v)[2][2]) const {
#pragma unroll
        for (int h = 0; h < 2; ++h)
#pragma unroll
            for (int i = 0; i < 2; ++i) v[h][i] = (unsigned)((h * HALF + R[i]) * ROWB + C[i] * 2); }
    __device__ __forceinline__ const char* b_base(const Unit& u) const { return (const char*)Bt + (size_t)u.pn * BM * ROWB; }
    __device__ __forceinline__ void hook(f32x4 (&)[2][2][4][2], const Unit&, int, int, int, int) const {}
    __device__ __forceinline__ void epi(const f32x4 (&acc)[2][2][4][2], const Unit& u, int wr, int wc, int fr, int fq) const {
        const int row0 = u.pm * BM + wr * 64 + fr, col0 = u.pn * BM + wc * 32 + 8 * fq;
        constexpr float inv = 1.f / (16.f * 256.f);
#pragma unroll
        for (int ai = 0; ai < 2; ++ai)
#pragma unroll
            for (int m = 0; m < 4; ++m) { bf16* rowp = O + (size_t)(row0 + ai * HALF + m * 16) * NPROJ + col0;
#pragma unroll
                for (int bj = 0; bj < 2; ++bj) { const f32x4 v0 = acc[ai][bj][m][0] * inv, v1 = acc[ai][bj][m][1] * inv;
                    u32x4 w; w.x = cvt_pk_bf16(v0[0], v0[1]); w.y = cvt_pk_bf16(v0[2], v0[3]); w.z = cvt_pk_bf16(v1[0], v1[1]); w.w = cvt_pk_bf16(v1[2], v1[3]);
                    *(u32x4*)(rowp + bj * HALF) = w; } }
    }
};
struct ProbE1 {
    static constexpr int STAMP_ID = 6;
    static constexpr int K = D, ROWB = D, KB = D; static constexpr bool PERM = true, HOOK = true, F8 = true, DENSE = true, ILV = false;
    const unsigned char* A; const unsigned char* Bt; const bf16* PJ; unsigned char* O; int G, c;
    __device__ __forceinline__ bool next(int i, Unit& u) const {
        if (G == 256) { if (i > 0) return false; const int x = c & 7, s = c >> 3; u.pm = x + 8 * (s >> 2); u.pn = s & 3; }
        else { const int L = i * G + c; if (L >= 64 * 4) return false; u.pm = L >> 2; u.pn = L & 3; }
        u.e = 0; u.rb = 0; return true; }
    __device__ __forceinline__ const char* a_base(const Unit& u) const { return (const char*)A + (size_t)u.pm * BM * ROWB; }
    __device__ __forceinline__ void a_offs(const Unit&, const int (&R)[2], const int (&C)[2], unsigned (&v)[2][2]) const {
#pragma unroll
        for (int h = 0; h < 2; ++h)
#pragma unroll
            for (int i = 0; i < 2; ++i) v[h][i] = (unsigned)((h * HALF + R[i]) * ROWB + C[i] * 2); }
    __device__ __forceinline__ const char* b_base(const Unit& u) const { return (const char*)Bt + (size_t)u.pn * BM * ROWB; }
    __device__ __forceinline__ void hook(f32x4 (&acc)[2][2][4][2], const Unit& u, int wr, int wc, int fr, int fq) const {
        int row0 = u.pm * BM + wr * 64 + fr, col0 = u.pn * BM + wc * 32 + 8 * fq;
        asm volatile("" : "+v"(row0), "+v"(col0));
#pragma unroll
        for (int ai = 0; ai < 2; ++ai) {
            u32x4 ga[4][2], gb[4][2];
#pragma unroll
            for (int m = 0; m < 4; ++m) { const bf16* rowp = PJ + (size_t)(row0 + ai * HALF + m * 16) * NPROJ + col0;
#pragma unroll
                for (int bj = 0; bj < 2; ++bj) { ga[m][bj] = *(const u32x4*)(rowp + P_GA + bj * HALF); gb[m][bj] = *(const u32x4*)(rowp + P_GB + bj * HALF); } }
#pragma unroll
            for (int m = 0; m < 4; ++m)
#pragma unroll
                for (int bj = 0; bj < 2; ++bj)
#pragma unroll
                    for (int q = 0; q < 4; ++q) { const float a0 = bf2f(ga[m][bj][q] & 0xffffu), a1 = bf2f(ga[m][bj][q] >> 16), b0 = bf2f(gb[m][bj][q] & 0xffffu), b1 = bf2f(gb[m][bj][q] >> 16);
                        const float r0 = (1.f + __expf(-b0)) * __builtin_amdgcn_rcpf(1.f + __expf(-a0)), r1 = (1.f + __expf(-b1)) * __builtin_amdgcn_rcpf(1.f + __expf(-a1));
                        acc[ai][bj][m][q >> 1][(q & 1) * 2] *= r0; acc[ai][bj][m][q >> 1][(q & 1) * 2 + 1] *= r1; }
            asm volatile("" ::: "memory"); }
    }
    __device__ __forceinline__ void epi(const f32x4 (&acc)[2][2][4][2], const Unit& u, int wr, int wc, int fr, int fq) const {
        int row0 = u.pm * BM + wr * 64 + fr, col0 = u.pn * BM + wc * 32 + 8 * fq;
        asm volatile("" : "+v"(row0), "+v"(col0));
#pragma unroll
        for (int ai = 0; ai < 2; ++ai) {
            u32x4 gb[4][2];
#pragma unroll
            for (int m = 0; m < 4; ++m)
#pragma unroll
                for (int bj = 0; bj < 2; ++bj) gb[m][bj] = *(const u32x4*)(PJ + (size_t)(row0 + ai * HALF + m * 16) * NPROJ + col0 + P_GB + bj * HALF);
#pragma unroll
            for (int m = 0; m < 4; ++m) { const size_t r = (size_t)(row0 + ai * HALF + m * 16);
#pragma unroll
                for (int bj = 0; bj < 2; ++bj) { float v[8];
#pragma unroll
                    for (int q = 0; q < 4; ++q) { v[2 * q] = acc[ai][bj][m][q >> 1][(q & 1) * 2] * (sigmf(bf2f(gb[m][bj][q] & 0xffffu)) * (1.f / 256.f)); v[2 * q + 1] = acc[ai][bj][m][q >> 1][(q & 1) * 2 + 1] * (sigmf(bf2f(gb[m][bj][q] >> 16)) * (1.f / 256.f)); }
                    u32x2 w; w.x = pk4_fp8(v[0], v[1], v[2], v[3]); w.y = pk4_fp8(v[4], v[5], v[6], v[7]);
                    *(u32x2*)(O + r * D + col0 + bj * HALF) = w; } }
            asm volatile("" ::: "memory"); }
    }
};
struct ProbE2 {
    static constexpr int STAMP_ID = 7;
    static constexpr int K = D, ROWB = D, KB = D; static constexpr bool PERM = true, HOOK = false, F8 = true, DENSE = true, ILV = false;
    const unsigned char* A; const unsigned char* Bt; const float* X; const float* mod; bf16* O; int G, c;
    __device__ __forceinline__ bool next(int i, Unit& u) const {
        if (G == 256) { if (i > 0) return false; const int x = c & 7, s = c >> 3; u.pm = x + 8 * (s >> 2); u.pn = s & 3; }
        else { const int L = i * G + c; if (L >= 64 * 4) return false; u.pm = L >> 2; u.pn = L & 3; }
        u.e = 0; u.rb = 0; return true; }
    __device__ __forceinline__ const char* a_base(const Unit& u) const { return (const char*)A + (size_t)u.pm * BM * ROWB; }
    __device__ __forceinline__ void a_offs(const Unit&, const int (&R)[2], const int (&C)[2], unsigned (&v)[2][2]) const {
#pragma unroll
        for (int h = 0; h < 2; ++h)
#pragma unroll
            for (int i = 0; i < 2; ++i) v[h][i] = (unsigned)((h * HALF + R[i]) * ROWB + C[i] * 2); }
    __device__ __forceinline__ const char* b_base(const Unit& u) const { return (const char*)Bt + (size_t)u.pn * BM * ROWB; }
    __device__ __forceinline__ void hook(f32x4 (&)[2][2][4][2], const Unit&, int, int, int, int) const {}
    __device__ __forceinline__ void epi(const f32x4 (&acc)[2][2][4][2], const Unit& u, int wr, int wc, int fr, int fq) const {
        const int row0 = u.pm * BM + wr * 64 + fr, col0 = u.pn * BM + wc * 32 + 8 * fq;
        const float* g1 = mod + (size_t)(u.pm / 8) * 6 * D + 2 * D;
        f32x4 gv[2][2];
#pragma unroll
        for (int bj = 0; bj < 2; ++bj)
#pragma unroll
            for (int n = 0; n < 2; ++n) gv[bj][n] = *(const f32x4*)(g1 + col0 + bj * HALF + 4 * n) * (1.f / (16.f * 256.f));
#pragma unroll
        for (int ai = 0; ai < 2; ++ai) {
            f32x4 xv[4][2][2];
#pragma unroll
            for (int m = 0; m < 4; ++m) { const size_t off = (size_t)(row0 + ai * HALF + m * 16) * D + col0;
#pragma unroll
                for (int bj = 0; bj < 2; ++bj)
#pragma unroll
                    for (int n = 0; n < 2; ++n) xv[m][bj][n] = __builtin_nontemporal_load((const f32x4*)(X + off + bj * HALF + 4 * n)); }
#pragma unroll
            for (int m = 0; m < 4; ++m) { const size_t off = (size_t)(row0 + ai * HALF + m * 16) * D + col0;
#pragma unroll
                for (int bj = 0; bj < 2; ++bj) { const f32x4 v0 = xv[m][bj][0] + gv[bj][0] * acc[ai][bj][m][0], v1 = xv[m][bj][1] + gv[bj][1] * acc[ai][bj][m][1];
                    u32x4 w; w.x = cvt_pk_bf16(v0[0], v0[1]); w.y = cvt_pk_bf16(v0[2], v0[3]); w.z = cvt_pk_bf16(v1[0], v1[1]); w.w = cvt_pk_bf16(v1[2], v1[3]);
                    *(u32x4*)(O + off + bj * HALF) = w; } }
            asm volatile("" ::: "memory"); }
    }
};
__device__ __forceinline__ void moe_tile_starts(Frame& F, volatile LAS int* mts) {
    if (F.wave == 0) { const int l = F.lane; const unsigned* cnt = (const unsigned*)(F.ws + WS_CTL) + CW_CNT;
        const int t = l < E ? (int)((cnt[l * 64] + 255u) >> 8) : 0; int incl = t;
#pragma unroll
        for (int o = 1; o < 32; o <<= 1) { const int u = __shfl_up(incl, o); if (l >= o) incl += u; }
        if (l < E) mts[l] = incl - t;
        if (l == E - 1) mts[E] = incl; }
    __syncthreads();
}
__device__ __forceinline__ int moe_find_expert(const volatile LAS int* mts, int mt) { int e = 0;
#pragma unroll
    for (int s = 16; s > 0; s >>= 1) { if (mts[e + s] <= mt) e += s; }
    return e; }
constexpr float SC_H = 16.f, SC_W = 256.f, SC_ACT = 4.f, SC_Y = 32.f;
struct ProbMoe1 {
    static constexpr int STAMP_ID = 9;
    static constexpr int K = D, ROWB = D, KB = D; static constexpr bool PERM = true, HOOK = false, F8 = true, DENSE = false, ILV = false;
    const unsigned char* A; const unsigned char* Bt; unsigned char* O; const float* b1; const int* tokl; const unsigned* cnt; const volatile LAS int* mts; int G, c, total;
    __device__ __forceinline__ bool next(int i, Unit& u) const {
        int mt, pn; if (G == 256) { const int x = c & 7, sl = c >> 3; mt = ((i * 8 + x) << 2) + (sl >> 3); pn = sl & 7; }
        else { const int L = i * G + c; mt = L >> 3; pn = L & 7; }
        if (mt >= total) return false;
        u.pm = mt; u.pn = pn; u.e = __builtin_amdgcn_readfirstlane(moe_find_expert(mts, mt)); u.rb = __builtin_amdgcn_readfirstlane((mt - mts[u.e]) * 256); return true; }
    __device__ __forceinline__ const char* a_base(const Unit&) const { return (const char*)A; }
    __device__ __forceinline__ void a_offs(const Unit& u, const int (&R)[2], const int (&C)[2], unsigned (&v)[2][2]) const {
        const int n = (int)cnt[u.e * 64]; const int* lst = tokl + (size_t)u.e * NT;
#pragma unroll
        for (int h = 0; h < 2; ++h)
#pragma unroll
            for (int i = 0; i < 2; ++i) v[h][i] = (unsigned)lst[u.rb + h * HALF + R[i]];
#pragma unroll
        for (int h = 0; h < 2; ++h)
#pragma unroll
            for (int i = 0; i < 2; ++i) { const int idx = u.rb + h * HALF + R[i]; const int tok = idx < n ? (int)v[h][i] : 0; v[h][i] = (unsigned)(tok * ROWB + C[i] * 2); } }
    __device__ __forceinline__ const char* b_base(const Unit& u) const { return (const char*)Bt + ((size_t)u.e * 2 * FF + (size_t)u.pn * BM) * ROWB; }
    __device__ __forceinline__ void hook(f32x4 (&)[2][2][4][2], const Unit&, int, int, int, int) const {}
    __device__ __forceinline__ void epi(const f32x4 (&acc)[2][2][4][2], const Unit& u, int wr, int wc, int fr, int fq) const {
        int row0 = u.pm * BM + wr * 64 + fr, col0 = u.pn * 128 + wc * 32 + 8 * fq;
        asm volatile("" : "+v"(row0), "+v"(col0));
        const float* bg = b1 + (size_t)u.e * 2 * FF + col0; f32x4 bgv[2], buv[2];
#pragma unroll
        for (int n = 0; n < 2; ++n) { bgv[n] = *(const f32x4*)(bg + 4 * n); buv[n] = *(const f32x4*)(bg + FF + 4 * n); }
        constexpr float inv = 1.f / (SC_H * SC_W);
#pragma unroll
        for (int ai = 0; ai < 2; ++ai)
#pragma unroll
            for (int m = 0; m < 4; ++m) { float v[8];
#pragma unroll
                for (int n = 0; n < 2; ++n)
#pragma unroll
                    for (int j = 0; j < 4; ++j) { const float gt = fminf(acc[ai][0][m][n][j] * inv + bgv[n][j], 7.f); const float up = fminf(fmaxf(acc[ai][1][m][n][j] * inv + buv[n][j], -7.f), 7.f);
                        v[4 * n + j] = __builtin_fmaf(up, SC_ACT, SC_ACT) * (gt * __builtin_amdgcn_rcpf(1.f + __builtin_amdgcn_exp2f(gt * (-1.702f * 1.44269504f)))); }
                u32x2 w; { int p0 = __builtin_amdgcn_cvt_pk_fp8_f32(v[0], v[1], 0, false); p0 = __builtin_amdgcn_cvt_pk_fp8_f32(v[2], v[3], p0, true);
                    int p1 = __builtin_amdgcn_cvt_pk_fp8_f32(v[4], v[5], 0, false); p1 = __builtin_amdgcn_cvt_pk_fp8_f32(v[6], v[7], p1, true); w.x = (unsigned)p0; w.y = (unsigned)p1; }
                *(u32x2*)(O + (size_t)(row0 + ai * HALF + m * 16) * FF + col0) = w; }
    }
};
struct ProbMoe2 {
    static constexpr int STAMP_ID = 10;
    static constexpr int K = FF, ROWB = FF, KB = FF; static constexpr bool PERM = true, HOOK = false, F8 = true, DENSE = true, ILV = true;
    const unsigned char* A; const unsigned char* Bt; unsigned char* O; const float* b2; const float* gatel; const unsigned* cnt; const volatile LAS int* mts; int G, c, total;
    __device__ __forceinline__ bool next(int i, Unit& u) const {
        int mt, pn; if (G == 256) { const int x = c & 7, sl = c >> 3; mt = ((i * 8 + x) << 3) + (sl >> 2); pn = sl & 3; }
        else { const int L = i * G + c; mt = L >> 2; pn = L & 3; }
        if (mt >= total) return false;
        u.pm = mt; u.pn = pn; u.e = __builtin_amdgcn_readfirstlane(moe_find_expert(mts, mt)); u.rb = __builtin_amdgcn_readfirstlane((mt - mts[u.e]) * 256); return true; }
    __device__ __forceinline__ const char* a_base(const Unit& u) const { return (const char*)A + (size_t)u.pm * BM * ROWB; }
    __device__ __forceinline__ void a_offs(const Unit&, const int (&R)[2], const int (&C)[2], unsigned (&v)[2][2]) const {
#pragma unroll
        for (int h = 0; h < 2; ++h)
#pragma unroll
            for (int i = 0; i < 2; ++i) v[h][i] = (unsigned)((h * HALF + R[i]) * ROWB + C[i] * 2); }
    __device__ __forceinline__ const char* b_base(const Unit& u) const { return (const char*)Bt + ((size_t)u.e * D + (size_t)u.pn * BM) * ROWB; }
    __device__ __forceinline__ void hook(f32x4 (&)[2][2][4][2], const Unit&, int, int, int, int) const {}
    __device__ __forceinline__ void epi(const f32x4 (&acc)[2][2][4][2], const Unit& u, int wr, int wc, int fr, int fq) const {
        int rloc = wr * 64 + fr, col0 = u.pn * BM + wc * 64 + 16 * fq;
        asm volatile("" : "+v"(rloc), "+v"(col0));
        const int n = (int)cnt[u.e * 64];
        const float* bb = b2 + (size_t)u.e * D + col0; const float* gl = gatel + (size_t)u.e * NT;
        constexpr float inv = 1.f / (SC_ACT * SC_W);
        f32x4 bv[2][2];
#pragma unroll
        for (int bj = 0; bj < 2; ++bj)
#pragma unroll
            for (int q = 0; q < 2; ++q) bv[bj][q] = *(const f32x4*)(bb + 8 * bj + 4 * q);
#pragma unroll
        for (int ai = 0; ai < 2; ++ai)
#pragma unroll
            for (int m = 0; m < 4; ++m) { const int rl = rloc + ai * HALF + m * 16; const int idx = u.rb + rl; const float graw = gl[idx]; const float gt = idx < n ? graw : 0.f;
                unsigned char* rowp = O + (size_t)(u.pm * BM + rl) * D + col0; const float gs = gt * SC_Y;
                u32x4 w;
#pragma unroll
                for (int bj = 0; bj < 2; ++bj) { const f32x4 v0 = (acc[ai][bj][m][0] * inv + bv[bj][0]) * gs, v1 = (acc[ai][bj][m][1] * inv + bv[bj][1]) * gs;
                    w[2 * bj] = pk4_fp8(v0[0], v0[1], v0[2], v0[3]); w[2 * bj + 1] = pk4_fp8(v1[0], v1[1], v1[2], v1[3]); }
                *(u32x4*)rowp = w; }
    }
};
__device__ __forceinline__ void final_phase(Frame& F, const Args& A, const volatile LAS int* mts) {
    const int gw = F.vcu * NWAVES + F.wave, NGW = F.G * NWAVES, lane = F.lane;
    const float* mod = (const float*)(F.ws + WS_MOD); const int* asg = (const int*)(F.ws + WS_ASG); const unsigned char* Y2 = (const unsigned char*)(F.ws + WS_Y2); const float* fw = A.in[23]; const bf16* XL2 = (const bf16*)(F.ws + WS_OF);
    f32x4 wv[4];
#pragma unroll
    for (int j = 0; j < 4; ++j) wv[j] = *((const f32x4*)fw + lane + 64 * j);
#define FP_ASG(dst, r) do { const int _r = (r) < NT ? (r) : gw; _Pragma("unroll") for (int _k = 0; _k < 4; ++_k) dst[_k] = asg[_r * 4 + _k]; } while (0)
#define FP_LOAD(Y, X, Gv, a, r) do { _Pragma("unroll") for (int _k = 0; _k < 4; ++_k) { const int _e = a[_k] >> 16, _pos = a[_k] & 0xffff; const size_t _slot = (size_t)mts[_e] * 256 + _pos; \
            const unsigned* _yp = (const unsigned*)(Y2 + _slot * D) + lane; _Pragma("unroll") for (int _j = 0; _j < 4; ++_j) Y[_k][_j] = (int)__builtin_nontemporal_load(_yp + 64 * _j); } \
        const float* _g2 = mod + (size_t)((r) / T) * 6 * D + 5 * D; \
        _Pragma("unroll") for (int _j = 0; _j < 4; ++_j) { X[_j] = __builtin_nontemporal_load((const u32x2*)(XL2 + (size_t)(r) * D) + lane + 64 * _j); Gv[_j] = *((const f32x4*)_g2 + lane + 64 * _j); } } while (0)
#define FP_COMP(Y, X, Gv, r) do { f32x4 _v[4]; float _ss = 0.f; \
        _Pragma("unroll") for (int _j = 0; _j < 4; ++_j) { f32x4 _m = (f32x4){0.f, 0.f, 0.f, 0.f}; \
            _Pragma("unroll") for (int _k = 0; _k < 4; ++_k) { const f32x2 _lo = __builtin_amdgcn_cvt_pk_f32_fp8(Y[_k][_j], false), _hi = __builtin_amdgcn_cvt_pk_f32_fp8(Y[_k][_j], true); _m.x += _lo.x; _m.y += _lo.y; _m.z += _hi.x; _m.w += _hi.y; } \
            const u32x2 _xw = X[_j]; const f32x4 _xv = (f32x4){__builtin_bit_cast(float, _xw.x << 16), __builtin_bit_cast(float, _xw.x & 0xffff0000u), __builtin_bit_cast(float, _xw.y << 16), __builtin_bit_cast(float, _xw.y & 0xffff0000u)}; \
            _v[_j] = _xv + Gv[_j] * (_m * (1.f / SC_Y)); _ss += (_v[_j].x * _v[_j].x + _v[_j].y * _v[_j].y) + (_v[_j].z * _v[_j].z + _v[_j].w * _v[_j].w); } \
        const float _rstd = rsqrtf(wave_sum(_ss) * (1.f / D) + EPS); \
        _Pragma("unroll") for (int _j = 0; _j < 4; ++_j) __builtin_nontemporal_store(_v[_j] * _rstd * wv[_j], (f32x4*)(A.out + (size_t)(r) * D) + lane + 64 * _j); } while (0)
    int aA[4], aB[4]; int YA[4][4], YB[4][4]; u32x2 XA[4], XB[4]; f32x4 GA[4], GB[4];
    int r = gw;
    if (r >= NT) return;
    FP_ASG(aA, r); FP_LOAD(YA, XA, GA, aA, r); FP_ASG(aB, r + NGW);
    for (; r < NT; r += 2 * NGW) {
        const bool hasB = r + NGW < NT;
        if (hasB) FP_LOAD(YB, XB, GB, aB, r + NGW);
        FP_ASG(aA, r + 2 * NGW);
        FP_COMP(YA, XA, GA, r);
        if (hasB) {
            if (r + 2 * NGW < NT) FP_LOAD(YA, XA, GA, aA, r + 2 * NGW);
            FP_ASG(aB, r + 3 * NGW);
            FP_COMP(YB, XB, GB, r + NGW);
        }
    }
#undef FP_ASG
#undef FP_LOAD
#undef FP_COMP
}
typedef short s16x4 __attribute__((ext_vector_type(4)));
constexpr int NA_VLAT = 0, NA_VCTX = 65536, NA_KCTX = 98304, NA_MRG = 131072, NA_MRG_W = 2304, NA_RPB = NA_MRG + 4 * NA_MRG_W, NA_END = NA_RPB + 15 * 32 * 4;
__device__ __forceinline__ void na_phase(Frame& F, const Args& A, int blk, int nblk, int wlo = -1, int whi = 0, int wtot = 1, int dynbase = -1) {
    const bf16* PJ = (const bf16*)(F.ws + WS_PROJ); bf16* OC = (bf16*)(F.ws + WS_OCAT); const float* rpb = A.in[8];
    const int tid = F.tid, lane = F.lane, wave = F.wave, g = lane >> 4, li = lane & 15;
    const int qb = wave & 3, half = wave >> 2;
    const int w0 = (qb == 0) ? 0 : (qb == 1) ? 8 : (qb == 2) ? 24 : 32;
    LAS unsigned char* lds = F.lds;
    LAS float* rpbs = (LAS float*)(lds + NA_RPB);
    LAS unsigned char* mrgb = lds + NA_MRG + qb * NA_MRG_W;
    unsigned kdl[2], vdl;
#pragma unroll
    for (int p = 0; p < 2; ++p) kdl[p] = (unsigned)((lane >> 3) * (NPROJ * 2) + 16 * ((lane & 7) ^ ((4 * p + (lane >> 4)) & 7)));
    vdl = (unsigned)((lane >> 3) * (NPROJ * 2) + 16 * (((((lane & 7) >> 1) ^ ((lane >> 4) & 3)) << 1) | (lane & 1)));
    const int ntask = NB * H * 32;
    const int t_lo = wlo < 0 ? (int)((long)ntask * blk / nblk) : (int)((long)ntask * wlo / wtot), t_hi = wlo < 0 ? (int)((long)ntask * (blk + 1) / nblk) : (int)((long)ntask * whi / wtot);
    const int fl = (2 * (g & 1) + ((li >> 2) >> 1)) & 3;
    int cur_bh = -1;
    unsigned* qctr = (unsigned*)(F.ws + WS_CTL) + 9600; volatile LAS int* qslot = (volatile LAS int*)(lds + NA_END);
    int task = t_lo, t_end = t_hi;
    for (;; ++task) {
        if (task >= t_end) {
            if (dynbase < 0) break;
            __syncthreads();
            if (tid == 0) *qslot = dynbase + (int)__hip_atomic_fetch_add(qctr, 1u, __ATOMIC_RELAXED, __HIP_MEMORY_SCOPE_AGENT);
            __syncthreads();
            task = *qslot; if (task >= ntask) break; t_end = task + 1; }
        const int bh = task >> 5, r = task & 31, b = bh >> 3, h = bh & 7;
        const int r0 = min(max(r - 4, 0), 24);
        __syncthreads();
        if (bh != cur_bh) {
            cur_bh = bh;
            const unsigned char* kc = (const unsigned char*)(PJ + (size_t)(NT + b * LC) * NPROJ + P_NAK + h * 64); const unsigned char* vc = (const unsigned char*)(PJ + (size_t)(NT + b * LC) * NPROJ + P_NAV + h * 64);
#pragma unroll
            for (int i = 0; i < 4; ++i) { const int pc = wave * 4 + i; unsigned vo = kdl[pc & 1]; asm volatile("" : "+v"(vo));
                __builtin_amdgcn_global_load_lds((const unsigned*)(kc + (size_t)pc * 8 * (NPROJ * 2) + vo), (LAS unsigned*)(lds + NA_KCTX + pc * 1024), 16, 0, 0);
                unsigned vv = vdl; asm volatile("" : "+v"(vv));
                __builtin_amdgcn_global_load_lds((const unsigned*)(vc + (size_t)pc * 8 * (NPROJ * 2) + vv), (LAS unsigned*)(lds + NA_VCTX + pc * 1024), 16, 0, 0); }
            if (tid < 15 * 32) { const int dr = tid >> 5, dc = tid & 31; rpbs[tid] = dc < 31 ? rpb[(h * 15 + dr) * 31 + dc] : 0.f; }
        }
        { const unsigned char* kb = (const unsigned char*)(PJ + (size_t)(b * T + r0 * 64) * NPROJ + P_NAK + h * 64);
#pragma unroll
            for (int i = 0; i < 8; ++i) { const int pc = wave * 8 + i; unsigned vo = kdl[pc & 1]; asm volatile("" : "+v"(vo));
                __builtin_amdgcn_global_load_lds((const unsigned*)(kb + (size_t)pc * 8 * (NPROJ * 2) + vo), (LAS unsigned*)(lds + NA_VLAT + pc * 1024), 16, 0, 0); } }
        const bf16* qp = PJ + (size_t)(b * T + r * 64 + 16 * qb + li) * NPROJ + P_NAQ + h * 64 + 8 * g;
        const bf16x8 Qf0 = *(const bf16x8*)qp, Qf1 = *(const bf16x8*)(qp + 32);
        asm volatile("s_waitcnt vmcnt(0)" ::: "memory");
        __syncthreads();
        f32x4 st[16];
        const int qc = 16 * qb + li, c0 = min(max(qc - 8, 0), 48);
        { const LAS unsigned char* kbase = lds + (half ? NA_KCTX : NA_VLAT);
#pragma unroll
            for (int hb = 0; hb < 2; ++hb) {
                bf16x8 Kf[8][2];
#pragma unroll
                for (int tt = 0; tt < 8; ++tt) { const int t = 8 * hb + tt; const int key = half ? (16 * t + li) : ((t >> 1) * 64 + w0 + 16 * (t & 1) + li); const int xs = (key >> 1) & 7;
                    Kf[tt][0] = *(const LAS bf16x8*)(kbase + key * 128 + 16 * (g ^ xs)); Kf[tt][1] = *(const LAS bf16x8*)(kbase + key * 128 + 16 * ((4 + g) ^ xs)); }
                __builtin_amdgcn_sched_barrier(0);
#pragma unroll
                for (int tt = 0; tt < 8; ++tt) { f32x4 acc = (f32x4){0.f, 0.f, 0.f, 0.f};
                    acc = __builtin_amdgcn_mfma_f32_16x16x32_bf16(Kf[tt][0], Qf0, acc, 0, 0, 0); acc = __builtin_amdgcn_mfma_f32_16x16x32_bf16(Kf[tt][1], Qf1, acc, 0, 0, 0); st[8 * hb + tt] = acc; }
                __builtin_amdgcn_sched_barrier(0);
            } }
        LDS_WAIT();
        __syncthreads();
        { const unsigned char* vb = (const unsigned char*)(PJ + (size_t)(b * T + r0 * 64) * NPROJ + P_NAV + h * 64);
#pragma unroll
            for (int i = 0; i < 8; ++i) { const int pc = wave * 8 + i; unsigned vv = vdl; asm volatile("" : "+v"(vv));
                __builtin_amdgcn_global_load_lds((const unsigned*)(vb + (size_t)pc * 8 * (NPROJ * 2) + vv), (LAS unsigned*)(lds + NA_VLAT + pc * 1024), 16, 0, 0); } }
        float mx = -3.0e38f;
        if (half == 0) {
#pragma unroll
            for (int t = 0; t < 16; ++t) { const int dr = r0 + (t >> 1) - r + 7;
#pragma unroll
                for (int rr = 0; rr < 4; ++rr) { const int kc = w0 + 16 * (t & 1) + 4 * g + rr; const bool valid = (kc >= c0) && (kc < c0 + 16);
                    const int dc = min(max(kc - qc + 15, 0), 30);
                    const float sb = st[t][rr] * 0.125f + rpbs[dr * 32 + dc];
                    const float s = valid ? sb : -1.0e30f; st[t][rr] = s; mx = fmaxf(mx, s); } }
        } else {
#pragma unroll
            for (int t = 0; t < 16; ++t)
#pragma unroll
                for (int rr = 0; rr < 4; ++rr) { const float s = st[t][rr] * 0.125f; st[t][rr] = s; mx = fmaxf(mx, s); }
        }
        mx = fmaxf(mx, __shfl_xor(mx, 16)); mx = fmaxf(mx, __shfl_xor(mx, 32));
        float sum = 0.f;
#pragma unroll
        for (int t = 0; t < 16; ++t)
#pragma unroll
            for (int rr = 0; rr < 4; ++rr) { const float p = __expf(st[t][rr] - mx); st[t][rr] = p; sum += p; }
        sum += __shfl_xor(sum, 16); sum += __shfl_xor(sum, 32);
        asm volatile("s_waitcnt vmcnt(0)" ::: "memory");
        __syncthreads();
        f32x4 o[4];
#pragma unroll
        for (int dt = 0; dt < 4; ++dt) o[dt] = (f32x4){0.f, 0.f, 0.f, 0.f};
        const int vrow0 = half ? (4 * g + (li >> 2)) : (w0 + 4 * g + (li >> 2));
        const unsigned vbase = (half ? NA_VCTX : NA_VLAT) + vrow0 * 128 + (li & 3) * 8;
        const int sstep = half ? 32 * 128 : 64 * 128;
#pragma unroll
        for (int s8 = 0; s8 < 8; ++s8) {
            u32x4 pw; pw.x = cvt_pk_bf16(st[2 * s8][0], st[2 * s8][1]); pw.y = cvt_pk_bf16(st[2 * s8][2], st[2 * s8][3]);
            pw.z = cvt_pk_bf16(st[2 * s8 + 1][0], st[2 * s8 + 1][1]); pw.w = cvt_pk_bf16(st[2 * s8 + 1][2], st[2 * s8 + 1][3]);
            const bf16x8 Pf = __builtin_bit_cast(bf16x8, pw);
#pragma unroll
            for (int dt = 0; dt < 4; ++dt) {
                const s16x4 v0 = __builtin_amdgcn_ds_read_tr16_b64_v4i16((LAS s16x4*)(lds + vbase + s8 * sstep + (dt ^ fl) * 32));
                const s16x4 v1 = __builtin_amdgcn_ds_read_tr16_b64_v4i16((LAS s16x4*)(lds + vbase + s8 * sstep + 16 * 128 + (dt ^ fl) * 32));
                bf16x8 Vf; Vf[0] = v0[0]; Vf[1] = v0[1]; Vf[2] = v0[2]; Vf[3] = v0[3]; Vf[4] = v1[0]; Vf[5] = v1[1]; Vf[6] = v1[2]; Vf[7] = v1[3];
                o[dt] = __builtin_amdgcn_mfma_f32_16x16x32_bf16(Pf, Vf, o[dt], 0, 0, 0);
            }
        }
        LAS bf16* mo = (LAS bf16*)mrgb; LAS float* mml = (LAS float*)(mrgb + 2048);
        if (half == 1) {
#pragma unroll
            for (int dt = 0; dt < 4; ++dt)
#pragma unroll
                for (int rr = 0; rr < 4; ++rr) mo[(dt * 4 + rr) * 64 + lane] = (bf16)f2bf(o[dt][rr]);
            if (lane < 16) { mml[lane] = mx; mml[16 + lane] = sum; }
        }
        __syncthreads();
        if (half == 0) {
            const float m2 = mml[li], l2 = mml[16 + li];
            const float M = fmaxf(mx, m2), a1 = __expf(mx - M), a2 = __expf(m2 - M), inv = __builtin_amdgcn_rcpf(sum * a1 + l2 * a2);
            const float f1 = a1 * inv, f2 = a2 * inv;
            float res[4][4];
#pragma unroll
            for (int rr = 0; rr < 4; ++rr) { const float f1q = __shfl(f1, 4 * g + rr), f2q = __shfl(f2, 4 * g + rr);
#pragma unroll
                for (int dt = 0; dt < 4; ++dt) res[dt][rr] = o[dt][rr] * f1q + bf2f(mo[(dt * 4 + rr) * 64 + lane]) * f2q; }
            LDS_WAIT(); asm volatile("" ::: "memory");
            LAS bf16* ot = mo;
#pragma unroll
            for (int dt = 0; dt < 4; ++dt)
#pragma unroll
                for (int rr = 0; rr < 4; ++rr) ot[(4 * g + rr) * 64 + 16 * dt + li] = (bf16)f2bf(res[dt][rr]);
            LDS_WAIT(); asm volatile("" ::: "memory");
#pragma unroll
            for (int i = 0; i < 2; ++i) { const int ch = lane + 64 * i, q = ch >> 3, c = ch & 7;
                const u32x4 v = *(const LAS u32x4*)(ot + q * 64 + 8 * c);
                u32x2 w8; w8.x = pk4_fp8(bf2f(v.x & 0xffffu) * 16.f, bf2f(v.x >> 16) * 16.f, bf2f(v.y & 0xffffu) * 16.f, bf2f(v.y >> 16) * 16.f); w8.y = pk4_fp8(bf2f(v.z & 0xffffu) * 16.f, bf2f(v.z >> 16) * 16.f, bf2f(v.w & 0xffffu) * 16.f, bf2f(v.w >> 16) * 16.f);
                *(u32x2*)((unsigned char*)OC + (size_t)(b * T + r * 64 + 16 * qb + q) * D + h * 64 + 8 * c) = w8; }
        }
    }
}
constexpr int DN_REC = 40960, DN_NCH = 36;
constexpr size_t WS_GL = 13 * MiB;
constexpr int DL_Q = 0, DL_K = 16384, DL_V = 32768, DL_KB = 49152, DL_QB = 58368, DL_KK = 67584, DL_QK = 84224, DL_AM = 100864, DL_SM = 135680;
constexpr int DL_AMS = 68;
__device__ __forceinline__ int dn_nat(int p) { return 32 * (p >> 5) + 16 * ((p & 7) >> 2) + 4 * ((p >> 3) & 3) + (p & 3); }

constexpr int DL_TL = DL_KB, DL_WIMG = DL_KK, DL_CW = DL_SM + 2560;
__device__ __forceinline__ bf16x8 dn_frag4(float a, float b, float c, float d) { u32x4 w; w.x = cvt_pk_bf16(a, b); w.y = cvt_pk_bf16(c, d); w.z = 0u; w.w = 0u; return __builtin_bit_cast(bf16x8, w); }

__device__ __forceinline__ void dn_prep(Frame& F, const Args& A) {
    const bf16* PJ = (const bf16*)(F.ws + WS_PROJ); const float* convw = A.in[9];
    const float* GG = (const float*)(F.ws + WS_G); const float* BETA = (const float*)(F.ws + WS_BETA); const float* rope = (const float*)(F.ws + WS_ROPE);
    unsigned char* DNOP = F.ws + WS_DNOP; float* GL = (float*)(F.ws + WS_GL);
    LAS unsigned char* lds = F.lds; const int tid0 = F.tid, wave = F.wave;
    LAS float* Qs = (LAS float*)(lds + DL_Q); LAS float* Ks = (LAS float*)(lds + DL_K); LAS float* Vs = (LAS float*)(lds + DL_V);
    LAS bf16* KB = (LAS bf16*)(lds + DL_KB); LAS bf16* QB = (LAS bf16*)(lds + DL_QB);
    LAS float* KK = (LAS float*)(lds + DL_KK); LAS float* QKM = (LAS float*)(lds + DL_QK); LAS float* AM = (LAS float*)(lds + DL_AM);
    LAS float* gcum = (LAS float*)(lds + DL_SM); LAS float* bet = gcum + 128; LAS float* eg = gcum + 256; LAS float* et = gcum + 384; LAS float* beg = gcum + 512;
    LAS float* TL = (LAS float*)(lds + DL_TL); LAS float* CW = (LAS float*)(lds + DL_CW);
    const int ntask = NB * H * DN_NCH;
    const bool blocked = (F.G == 256);
    const int nloc = blocked ? 9 : (ntask - (int)blockIdx.x + F.G - 1) / F.G;
#define DN_TASK(k) (blocked ? ((int)blockIdx.x >> 2) * DN_NCH + ((int)blockIdx.x & 3) * 9 + (k) : (int)blockIdx.x + (k) * F.G)
#define DN_PREFETCH(kk, tv) do { const bool _ok = (kk) < nloc; const int _tk = _ok ? DN_TASK(kk) : 0; const int _it = (tv); \
        _Pragma("unroll") for (int _r = 0; _r < 8; ++_r) pre[_r] = (u32x4){0u, 0u, 0u, 0u}; \
        if (_ok && _it < 384) { const int _bh = _tk / DN_NCH, _j = _tk % DN_NCH, _b = _bh >> 3, _h = _bh & 7; const bool _lat = _j >= 4; \
            const int _t0 = _lat ? (_j - 4) * 64 : _j * 64, _tlen = _lat ? T : LC, _rb = _lat ? _b * T : NT + _b * LC; const int _c = _it % 24, _tq = _it / 24, _ch = (_c >> 3) * 512 + _h * 64 + (_c & 7) * 8; \
            _Pragma("unroll") for (int _r = 0; _r < 8; ++_r) { const int _s = _t0 + 4 * _tq - 2 + _r; if (_s >= 0 && _s < _tlen) pre[_r] = __builtin_nontemporal_load((const u32x4*)(PJ + (size_t)(_rb + _s) * NPROJ + P_DQ + _ch)); } } } while (0)
    u32x4 pre[8];
    DN_PREFETCH(0, tid0);
    f32x4 rpre[4]; float gpre = 0.f, bpre = 0.f;
#define DN_PRESMALL(kk, tv) do { const bool _ok = (kk) < nloc; const int _tk = _ok ? DN_TASK(kk) : DN_TASK(0); const int _bh = _tk / DN_NCH, _j = _tk % DN_NCH, _b = _bh >> 3, _h = _bh & 7; const bool _lat = _j >= 4; \
        const int _t0 = _lat ? (_j - 4) * 64 : _j * 64, _rb = _lat ? _b * T : NT + _b * LC; const int _tv = (tv); \
        { const float* _rp = rope + (size_t)((_lat ? _t0 : 0) + ((_tv >> 2) & 63)) * 64 + (_tv & 3) * 16; \
          rpre[0] = *(const f32x4*)_rp; rpre[1] = *(const f32x4*)(_rp + 4); rpre[2] = *(const f32x4*)(_rp + 8); rpre[3] = *(const f32x4*)(_rp + 12); } \
        if (_tv < 128) { const int _d = _tv >> 6, _ln = _tv & 63, _tok = _d ? 63 - _ln : _ln; const size_t _row = (size_t)(_rb + _t0 + _tok); gpre = GG[_row * 16 + _d * 8 + _h]; bpre = BETA[_row * 16 + _d * 8 + _h]; } } while (0)
    DN_PRESMALL(0, tid0);
    int cur_h = -1;
    for (int kt = 0; kt < nloc; ++kt) {
        const int task = DN_TASK(kt);
        const int bh = task / DN_NCH, j = task % DN_NCH, b = bh >> 3, h = bh & 7;
        const bool lat = j >= 4; const int t0 = lat ? (j - 4) * 64 : j * 64, rowbase = lat ? b * T : NT + b * LC;
        int tid = tid0; asm volatile("" : "+v"(tid));
        const int lane = tid & 63, g = lane >> 4, li = lane & 15;
        LDS_BARRIER();
        if (h != cur_h) { cur_h = h; for (int u = tid; u < 960; u += NTHR) { const int tp = u / 192, q = u % 192; CW[u] = convw[tp * 1536 + (q >> 6) * 512 + h * 64 + (q & 63)]; } LDS_BARRIER(); }
        if (tid < 384) { const int it = tid; const int c = it % 24, tq = it / 24, part = c >> 3, d0 = (c & 7) * 8;
            float xin[8][8];
#pragma unroll
            for (int rr = 0; rr < 8; ++rr) { const u32x4 w = pre[rr];
#pragma unroll
                for (int e = 0; e < 4; ++e) { xin[rr][2 * e] = bf2f(w[e] & 0xffffu); xin[rr][2 * e + 1] = bf2f(w[e] >> 16); } }
            float wt[5][8];
#pragma unroll
            for (int tp = 0; tp < 5; ++tp) { const f32x4 w0 = *(const LAS f32x4*)(CW + tp * 192 + part * 64 + d0), w1 = *(const LAS f32x4*)(CW + tp * 192 + part * 64 + d0 + 4);
#pragma unroll
                for (int e = 0; e < 4; ++e) { wt[tp][e] = w0[e]; wt[tp][4 + e] = w1[e]; } }
            LAS float* dst = (part == 0 ? Qs : part == 1 ? Ks : Vs);
#pragma unroll
            for (int tt = 0; tt < 4; ++tt) { float o[8];
#pragma unroll
                for (int e = 0; e < 8; ++e) { float a = 0.f;
#pragma unroll
                    for (int tp = 0; tp < 5; ++tp) a += xin[tt + tp][e] * wt[tp][e];
                    o[e] = a * __builtin_amdgcn_rcpf(1.f + __expf(-a)); }
                *(LAS f32x4*)(dst + (4 * tq + tt) * 64 + d0) = (f32x4){o[0], o[1], o[2], o[3]}; *(LAS f32x4*)(dst + (4 * tq + tt) * 64 + d0 + 4) = (f32x4){o[4], o[5], o[6], o[7]}; } }
        DN_PREFETCH(kt + 1, tid);
        LDS_BARRIER();
        { const int row = tid >> 2, qr = tid & 3; const bool isq = row < 64; const int tok = row & 63;
            LAS float* X = (isq ? Qs : Ks) + tok * 64 + qr * 8; LAS bf16* Y = (isq ? QB : KB) + tok * 72 + qr * 8;
            const f32x4 a0 = *(const LAS f32x4*)X, a1 = *(const LAS f32x4*)(X + 4), b0 = *(const LAS f32x4*)(X + 32), b1 = *(const LAS f32x4*)(X + 36);
            float x1[8] = {a0[0], a0[1], a0[2], a0[3], a1[0], a1[1], a1[2], a1[3]}, x2[8] = {b0[0], b0[1], b0[2], b0[3], b1[0], b1[1], b1[2], b1[3]};
            float ss = 0.f;
#pragma unroll
            for (int e = 0; e < 8; ++e) ss += x1[e] * x1[e] + x2[e] * x2[e];
            ss += __shfl_xor(ss, 1); ss += __shfl_xor(ss, 2);
            const float sc = rsqrtf(ss + EPS) * (isq ? 0.125f : 1.f);
            if (lat) { const f32x4 r0 = rpre[0], r1 = rpre[1], r2 = rpre[2], r3 = rpre[3];
                const float cs[8] = {r0[0], r0[2], r1[0], r1[2], r2[0], r2[2], r3[0], r3[2]}, sn[8] = {r0[1], r0[3], r1[1], r1[3], r2[1], r2[3], r3[1], r3[3]};
#pragma unroll
                for (int e = 0; e < 8; ++e) { const float u = x1[e], v = x2[e]; x1[e] = (u * cs[e] - v * sn[e]) * sc; x2[e] = (u * sn[e] + v * cs[e]) * sc; } }
            else {
#pragma unroll
                for (int e = 0; e < 8; ++e) { x1[e] *= sc; x2[e] *= sc; } }
            *(LAS f32x4*)X = (f32x4){x1[0], x1[1], x1[2], x1[3]}; *(LAS f32x4*)(X + 4) = (f32x4){x1[4], x1[5], x1[6], x1[7]};
            *(LAS f32x4*)(X + 32) = (f32x4){x2[0], x2[1], x2[2], x2[3]}; *(LAS f32x4*)(X + 36) = (f32x4){x2[4], x2[5], x2[6], x2[7]};
            u32x4 w0, w1; w0.x = pk2(x1[0], x1[1]); w0.y = pk2(x1[2], x1[3]); w0.z = pk2(x1[4], x1[5]); w0.w = pk2(x1[6], x1[7]); w1.x = pk2(x2[0], x2[1]); w1.y = pk2(x2[2], x2[3]); w1.z = pk2(x2[4], x2[5]); w1.w = pk2(x2[6], x2[7]);
            *(LAS u32x4*)Y = w0; *(LAS u32x4*)(Y + 32) = w1; }
        if (wave < 2) { const int d = wave; const int tok = d ? 63 - lane : lane; const size_t row = (size_t)(rowbase + t0 + tok);
            const float gi = gpre, bi = bpre; float cs = gi; (void)row;
#pragma unroll
            for (int o = 1; o < 64; o <<= 1) { const float t = __shfl_up(cs, o); if (lane >= o) cs += t; }
            const float last = __shfl(cs, 63);
            gcum[d * 64 + lane] = cs; bet[d * 64 + lane] = bi; eg[d * 64 + lane] = __expf(cs); et[d * 64 + lane] = __expf(last - cs); beg[d * 64 + lane] = bi * __expf(cs);
            const int c = d ? (lat ? 39 - j : 3 - j) : j;
            if (lane == 0) GL[(size_t)(bh * 2 + d) * DN_NCH + c] = __expf(last); }
        LDS_BARRIER();
        DN_PRESMALL(kt + 1, tid);
#pragma unroll
        for (int tl = 0; tl < 2; ++tl) { const int idx = wave * 2 + tl, mt = idx >> 2, nt = idx & 3;
            f32x4 akk = (f32x4){0.f, 0.f, 0.f, 0.f}, aqk = (f32x4){0.f, 0.f, 0.f, 0.f};
#pragma unroll
            for (int s = 0; s < 2; ++s) { const bf16x8 ka = *(const LAS bf16x8*)(KB + (16 * mt + li) * 72 + 8 * g + 32 * s), qa = *(const LAS bf16x8*)(QB + (16 * mt + li) * 72 + 8 * g + 32 * s),
                                                        kb = *(const LAS bf16x8*)(KB + (16 * nt + li) * 72 + 8 * g + 32 * s);
                akk = __builtin_amdgcn_mfma_f32_16x16x32_bf16(ka, kb, akk, 0, 0, 0); aqk = __builtin_amdgcn_mfma_f32_16x16x32_bf16(qa, kb, aqk, 0, 0, 0); }
#pragma unroll
            for (int rr = 0; rr < 4; ++rr) { KK[(16 * mt + 4 * g + rr) * 65 + 16 * nt + li] = akk[rr]; QKM[(16 * mt + 4 * g + rr) * 65 + 16 * nt + li] = aqk[rr]; } }
        LDS_BARRIER();
        { const int i = tid >> 3, sg = tid & 7;
#pragma unroll
            for (int d = 0; d < 2; ++d) { const int pi = d ? 63 - i : i; const float gi = gcum[d * 64 + i], bi = bet[d * 64 + i]; float v[8];
#pragma unroll
                for (int e = 0; e < 8; ++e) { const int jj = sg * 8 + e, pj = d ? 63 - jj : jj; v[e] = KK[pi * 65 + pj]; }
                const f32x4 gc0 = *(const LAS f32x4*)(gcum + d * 64 + sg * 8), gc1 = *(const LAS f32x4*)(gcum + d * 64 + sg * 8 + 4);
#pragma unroll
                for (int e = 0; e < 8; ++e) { const int jj = sg * 8 + e; const float ex = __expf(gi - (e < 4 ? gc0[e & 3] : gc1[e & 3])); const float t = bi * v[e] * ex; v[e] = (i > jj) ? t : 0.f; }
                *(LAS f32x4*)(AM + d * 64 * DL_AMS + i * DL_AMS + sg * 8) = (f32x4){v[0], v[1], v[2], v[3]}; *(LAS f32x4*)(AM + d * 64 * DL_AMS + i * DL_AMS + sg * 8 + 4) = (f32x4){v[4], v[5], v[6], v[7]}; } }
        LDS_BARRIER();
        if (wave < 2) {
            const int d = wave, I = lane >> 4, c = lane & 15; const LAS float* Ab = AM + d * 64 * DL_AMS + (16 * I) * DL_AMS + 16 * I;
            float t[16];
#pragma unroll
            for (int i = 0; i < 16; ++i) { float s0 = (i == c) ? 1.f : 0.f, s1 = 0.f;
#pragma unroll
                for (int j4 = 0; j4 < (i + 3) / 4; ++j4) { const f32x4 av = *(const LAS f32x4*)(Ab + i * DL_AMS + 4 * j4);
#pragma unroll
                    for (int e = 0; e < 4; ++e) if (4 * j4 + e < i) { if (e & 1) s1 -= av[e] * t[4 * j4 + e]; else s0 -= av[e] * t[4 * j4 + e]; } }
                t[i] = s0 + s1;
                if ((i & 3) == 3) asm volatile("" ::: "memory"); }
#pragma unroll
            for (int i = 0; i < 16; ++i) TL[(d * 4 + I) * 256 + i * 16 + c] = t[i];
        } else {
            const int t3 = tid - 128;
#pragma unroll
            for (int d = 0; d < 2; ++d) { const int cc = d ? (lat ? 39 - j : 3 - j) : j; unsigned char* rec = DNOP + ((size_t)(bh * 2 + d) * DN_NCH + cc) * DN_REC;
#pragma unroll
                for (int itk = 0; itk < 4; ++itk) { const int it = t3 + 384 * itk; const int mat = it >> 9, q9 = it & 511; float v[8];
                    if (mat < 2) { const int i = q9 >> 3, ch = q9 & 7, n0 = 32 * (ch >> 2) + 4 * (ch & 3), pi = d ? 63 - i : i;
                        if (mat == 0) { const float e = eg[d * 64 + i];
#pragma unroll
                            for (int jx = 0; jx < 8; ++jx) v[jx] = Qs[pi * 64 + n0 + 16 * (jx >> 2) + (jx & 3)] * e; }
                        else { const float gi = gcum[d * 64 + i];
#pragma unroll
                            for (int jx = 0; jx < 8; ++jx) { const int n = n0 + 16 * (jx >> 2) + (jx & 3), pj = d ? 63 - n : n; v[jx] = QKM[pi * 65 + pj]; }
                            const f32x4 gc0 = *(const LAS f32x4*)(gcum + d * 64 + n0), gc1 = *(const LAS f32x4*)(gcum + d * 64 + n0 + 16);
#pragma unroll
                            for (int jx = 0; jx < 8; ++jx) { const int n = n0 + 16 * (jx >> 2) + (jx & 3); const float t = v[jx] * __expf(gi - (jx < 4 ? gc0[jx & 3] : gc1[jx & 3])); v[jx] = (i >= n) ? t : 0.f; } }
                        u32x4 w; w.x = pk2(v[0], v[1]); w.y = pk2(v[2], v[3]); w.z = pk2(v[4], v[5]); w.w = pk2(v[6], v[7]);
                        *(u32x4*)(rec + (mat == 0 ? 8192 : 16384) + (i * 64 + ch * 8) * 2) = w; }
                    else { const int dk = q9 & 63, ch = q9 >> 6, n0 = 32 * (ch >> 2) + 4 * (ch & 3);
#pragma unroll
                        for (int jx = 0; jx < 8; ++jx) { const int n = n0 + 16 * (jx >> 2) + (jx & 3), pn = d ? 63 - n : n; v[jx] = Ks[pn * 64 + dk] * et[d * 64 + n]; }
                        u32x4 w; w.x = pk2(v[0], v[1]); w.y = pk2(v[2], v[3]); w.z = pk2(v[4], v[5]); w.w = pk2(v[6], v[7]);
                        *(u32x4*)(rec + 24576 + (dk * 64 + ch * 8) * 2) = w; } } }
        }
        LDS_BARRIER();
        { bf16x8 Xb[2][3]; const LAS float* Rs[2]; const LAS float* scl[2]; const LAS float* Am[2]; const LAS float* TLd[2]; unsigned char* rec[2]; LAS bf16* img[2]; int dd[2], isw[2], nt[2], pcol[2];
#pragma unroll
            for (int q = 0; q < 2; ++q) { const int item = wave * 2 + q; dd[q] = item >> 3; isw[q] = (item >> 2) & 1; nt[q] = item & 3;
                Rs[q] = (isw[q] ? Ks : Vs) + 16 * nt[q] + li; scl[q] = (isw[q] ? beg : bet) + dd[q] * 64; Am[q] = AM + dd[q] * 64 * DL_AMS; TLd[q] = TL + dd[q] * 4 * 256;
                const int cc = dd[q] ? (lat ? 39 - j : 3 - j) : j; rec[q] = DNOP + ((size_t)(bh * 2 + dd[q]) * DN_NCH + cc) * DN_REC; img[q] = (LAS bf16*)(lds + DL_WIMG + dd[q] * 8192);
                const int cdk = 16 * nt[q] + li; pcol[q] = 32 * (cdk >> 5) + 8 * ((cdk >> 2) & 3) + 4 * ((cdk >> 4) & 1) + (cdk & 3); }
#pragma unroll
            for (int I = 0; I < 4; ++I) {
                f32x4 acc[2], X[2];
#pragma unroll
                for (int q = 0; q < 2; ++q)
#pragma unroll
                    for (int r = 0; r < 4; ++r) { const int i = 16 * I + 4 * g + r, pi = dd[q] ? 63 - i : i; acc[q][r] = Rs[q][pi * 64] * scl[q][i]; }
#pragma unroll
                for (int J = 0; J < I; ++J)
#pragma unroll
                    for (int q = 0; q < 2; ++q) { const f32x4 a4 = *(const LAS f32x4*)(Am[q] + (16 * I + li) * DL_AMS + 16 * J + 4 * g);
                        acc[q] = __builtin_amdgcn_mfma_f32_16x16x32_bf16(dn_frag4(-a4[0], -a4[1], -a4[2], -a4[3]), Xb[q][J], acc[q], 0, 0, 0); }
#pragma unroll
                for (int q = 0; q < 2; ++q) { const f32x4 t4 = *(const LAS f32x4*)(TLd[q] + I * 256 + li * 16 + 4 * g);
                    X[q] = __builtin_amdgcn_mfma_f32_16x16x32_bf16(dn_frag4(t4[0], t4[1], t4[2], t4[3]), dn_frag4(acc[q][0], acc[q][1], acc[q][2], acc[q][3]), (f32x4){0.f, 0.f, 0.f, 0.f}, 0, 0, 0); }
#pragma unroll
                for (int q = 0; q < 2; ++q) {
                    if (I < 3) Xb[q][I] = dn_frag4(X[q][0], X[q][1], X[q][2], X[q][3]);
                    if (isw[q]) {
#pragma unroll
                        for (int r = 0; r < 4; ++r) img[q][(16 * I + 4 * g + r) * 64 + pcol[q]] = (bf16)f2bf(-X[q][r]); }
                    else { u32x2 w; w.x = cvt_pk_bf16(X[q][0], X[q][1]); w.y = cvt_pk_bf16(X[q][2], X[q][3]); *(u32x2*)(rec[q] + 32768 + (((nt[q] * 64 + lane) * 4 + I) * 4) * 2) = w; } }
            } }
        LDS_BARRIER();
#pragma unroll
        for (int q = 0; q < 2; ++q) { const int ch = tid + NTHR * q, d = ch >> 9, c9 = ch & 511;
            const int cc = d ? (lat ? 39 - j : 3 - j) : j; unsigned char* rec = DNOP + ((size_t)(bh * 2 + d) * DN_NCH + cc) * DN_REC;
            *(u32x4*)(rec + c9 * 16) = *(const LAS u32x4*)(lds + DL_WIMG + d * 8192 + c9 * 16); }
    }
#undef DN_TASK
#undef DN_PREFETCH
#undef DN_PRESMALL
}

constexpr int CW_FLAG = 8192;
__device__ __forceinline__ void dn_out_range(Frame& F, const Args& A, int pair, int tlo, int thi) {
    const bf16* OF16 = (const bf16*)(F.ws + WS_OF); const bf16* OB16 = OF16 + (size_t)NT * 512; const bf16* PJ = (const bf16*)(F.ws + WS_PROJ); bf16* OC = (bf16*)(F.ws + WS_OCAT); const float* nw = A.in[12];
    const int pb = pair >> 3, ph = pair & 7;
    const int hc = ph * 8 + (F.tid & 7); const f32x4 w0 = *(const f32x4*)(nw + (hc & 7) * 8), w1 = *(const f32x4*)(nw + (hc & 7) * 8 + 4);
    const int nit = (thi - tlo) * 8;
    for (int it0 = F.tid; it0 < nit; it0 += 4 * NTHR) {
        u32x4 av[4], bv[4], gw[4];
#pragma unroll
        for (int u = 0; u < 4; ++u) { const int it = min(it0 + u * NTHR, nit - 8 + (F.tid & 7)); const size_t tok = (size_t)pb * T + tlo + (it >> 3);
            av[u] = __builtin_nontemporal_load((const u32x4*)(OF16 + tok * 512 + hc * 8)); bv[u] = __builtin_nontemporal_load((const u32x4*)(OB16 + tok * 512 + hc * 8));
            gw[u] = *(const u32x4*)(PJ + tok * NPROJ + P_DG + hc * 8); }
#pragma unroll
        for (int u = 0; u < 4; ++u) { const int it = min(it0 + u * NTHR, nit - 8 + (F.tid & 7)); const size_t tok = (size_t)pb * T + tlo + (it >> 3);
            float v[8]; float ss = 0.f;
#pragma unroll
            for (int e = 0; e < 4; ++e) { v[2 * e] = bf2f(av[u][e] & 0xffffu) + bf2f(bv[u][e] & 0xffffu); v[2 * e + 1] = bf2f(av[u][e] >> 16) + bf2f(bv[u][e] >> 16); }
#pragma unroll
            for (int e = 0; e < 8; ++e) ss += v[e] * v[e];
            ss += __shfl_xor(ss, 1); ss += __shfl_xor(ss, 2); ss += __shfl_xor(ss, 4);
            const float rstd = rsqrtf(ss * (1.f / 64.f) + EPS);
            float o[8];
#pragma unroll
            for (int e = 0; e < 8; ++e) { const float z = bf2f(e & 1 ? gw[u][e >> 1] >> 16 : gw[u][e >> 1] & 0xffffu); const float wv = e < 4 ? w0[e] : w1[e - 4]; o[e] = v[e] * rstd * wv * (z * __builtin_amdgcn_rcpf(1.f + __expf(-z))); }
            u32x2 w; w.x = pk4_fp8(o[0] * 16.f, o[1] * 16.f, o[2] * 16.f, o[3] * 16.f); w.y = pk4_fp8(o[4] * 16.f, o[5] * 16.f, o[6] * 16.f, o[7] * 16.f);
            *(u32x2*)((unsigned char*)OC + tok * D + 512 + hc * 8) = w; }
    }
}
__device__ __forceinline__ void dn_out_items(Frame& F, const Args& A, int nb, int nna, int parts = 3, unsigned need = 1u) {
    unsigned* flags = (unsigned*)(F.ws + WS_CTL) + CW_FLAG; unsigned* tmo = (unsigned*)(F.ws + WS_CTL) + CW_BAR + XB_TMO;
    for (int item = nb; item < NB * H * parts; item += nna) { const int pair = item / parts, th = item % parts;
        __syncthreads();
        if (F.tid == 0) { unsigned sp = 0; while (__hip_atomic_load(flags + pair * 16, __ATOMIC_RELAXED, __HIP_MEMORY_SCOPE_AGENT) < need) { __builtin_amdgcn_s_sleep(2);
                if ((++sp & 255u) == 0u) { if (xb_ld(tmo)) break; if (sp > XB_SPIN_CAP) { atomicAdd(tmo, 1u); break; } } }
            __builtin_amdgcn_fence(__ATOMIC_ACQUIRE, "agent"); asm volatile("s_waitcnt vmcnt(0)" ::: "memory"); }
        __syncthreads();
        dn_out_range(F, A, pair, (T * th) / parts, (T * (th + 1)) / parts); }
}
constexpr int SC_MAT = 8192, SC_SEQ = 4 * SC_MAT, SC_BUF = 2 * SC_SEQ;
__device__ __forceinline__ void dn_scan(Frame& F, const Args& A, int blk, int nblk, bool fold) {
    const unsigned char* DNOP = F.ws + WS_DNOP; const float* GL = (const float*)(F.ws + WS_GL);
    float* OFB = (float*)(F.ws + WS_OF);
    const int lane = F.lane, g = lane >> 4, li = lane & 15, wq = F.wave & 3, sh = F.wave >> 2;
    unsigned srcl[2];
#pragma unroll
    for (int p = 0; p < 2; ++p) srcl[p] = (unsigned)(((lane & ~7) | ((lane & 7) ^ ((4 * p + (lane >> 4)) & 7))) * 16);
    const int xs = (li >> 1) & 7;
    const int fo0 = li * 128 + 16 * (g ^ xs), fo1 = li * 128 + 16 * ((4 + g) ^ xs);
    for (int pair = blk; pair < NB * H; pair += nblk) {
        const int seq = pair * 2 + sh, sl = wq, b = seq >> 4, h = (seq >> 1) & 7, d = seq & 1;
        f32x4 S[4];
#pragma unroll
        for (int m = 0; m < 4; ++m) S[m] = (f32x4){0.f, 0.f, 0.f, 0.f};
        const int sgn = d ? -1 : 1; const int obase_s = d * NT * 512 + b * T * 512;
        LAS bf16* oscr = (LAS bf16*)(F.lds + 2 * SC_BUF + F.wave * 1024); bf16* OFB16 = (bf16*)OFB;
        const unsigned char* rec0 = DNOP + (size_t)seq * DN_NCH * DN_REC;
        u32x2 pu[4];
        __syncthreads();
#define SC_DMA(cn) do { const unsigned char* _rn = rec0 + (size_t)(cn) * DN_REC; LAS unsigned char* _db = F.lds + ((cn) & 1) * SC_BUF + sh * SC_SEQ + wq * 8192; \
        _Pragma("unroll") for (int _i = 0; _i < 8; ++_i) { unsigned _vo = srcl[_i & 1]; asm volatile("" : "+v"(_vo)); __builtin_amdgcn_global_load_lds((const unsigned*)(_rn + (wq * 8 + _i) * 1024 + _vo), (LAS unsigned*)(_db + _i * 1024), 16, 0, 2); } } while (0)
#define SC_STORE(cp) do { const int _tok0 = d ? (64 * (31 - ((cp) - 4)) + 63) : 64 * ((cp) - 4); _Pragma("unroll") for (int _hf = 0; _hf < 2; ++_hf) { \
            _Pragma("unroll") for (int _m = 0; _m < 2; ++_m) _Pragma("unroll") for (int _r = 0; _r < 4; ++_r) oscr[(16 * _m + 4 * g + _r) * 16 + li] = (bf16)f2bf(opend[2 * _hf + _m][_r]); \
            LDS_WAIT(); asm volatile("" ::: "memory"); const u32x4 _v = *(const LAS u32x4*)(oscr + (lane >> 1) * 16 + (lane & 1) * 8); LDS_WAIT(); asm volatile("" ::: "memory"); \
            *(u32x4*)(OFB16 + (size_t)obase_s + (size_t)(_tok0 + (32 * _hf + (lane >> 1)) * sgn) * 512 + h * 64 + 16 * sl + (lane & 1) * 8) = _v; } } while (0)
        SC_DMA(0);
        { const u32x4 ua = __builtin_nontemporal_load((const u32x4*)(rec0 + 32768 + (sl * 64 + lane) * 32)), ub = __builtin_nontemporal_load((const u32x4*)(rec0 + 32768 + (sl * 64 + lane) * 32 + 16));
            pu[0] = (u32x2){ua.x, ua.y}; pu[1] = (u32x2){ua.z, ua.w}; pu[2] = (u32x2){ub.x, ub.y}; pu[3] = (u32x2){ub.z, ub.w}; }
        f32x4 opend[4];
#pragma unroll
        for (int m = 0; m < 4; ++m) opend[m] = (f32x4){0.f, 0.f, 0.f, 0.f};
        for (int c = 0; c < DN_NCH; ++c) {
            const float gl = GL[(size_t)seq * DN_NCH + c];
            f32x4 vn[4];
#pragma unroll
            for (int m = 0; m < 4; ++m) vn[m] = (f32x4){bf2f(pu[m].x & 0xffffu), bf2f(pu[m].x >> 16), bf2f(pu[m].y & 0xffffu), bf2f(pu[m].y >> 16)};
            asm volatile("s_waitcnt vmcnt(0)" ::: "memory");
            __syncthreads();
            if (c + 1 < DN_NCH) { SC_DMA(c + 1);
                const unsigned char* up = rec0 + (size_t)(c + 1) * DN_REC + 32768 + (sl * 64 + lane) * 32; const u32x4 ua = __builtin_nontemporal_load((const u32x4*)up), ub = __builtin_nontemporal_load((const u32x4*)(up + 16));
                pu[0] = (u32x2){ua.x, ua.y}; pu[1] = (u32x2){ua.z, ua.w}; pu[2] = (u32x2){ub.x, ub.y}; pu[3] = (u32x2){ub.z, ub.w}; }
            if (c >= 5) SC_STORE(c - 1);
            const LAS unsigned char* sb = F.lds + (c & 1) * SC_BUF + sh * SC_SEQ;
            bf16x8 fW[4][2], fD[4][2], fK[4][2];
#pragma unroll
            for (int m = 0; m < 4; ++m) { fW[m][0] = *(const LAS bf16x8*)(sb + m * 2048 + fo0); fW[m][1] = *(const LAS bf16x8*)(sb + m * 2048 + fo1); }
            __builtin_amdgcn_sched_barrier(0);
            bf16x8 Sb[2], Vb[2];
#pragma unroll
            for (int s = 0; s < 2; ++s) { u32x4 w; w.x = cvt_pk_bf16(S[2 * s][0], S[2 * s][1]); w.y = cvt_pk_bf16(S[2 * s][2], S[2 * s][3]); w.z = cvt_pk_bf16(S[2 * s + 1][0], S[2 * s + 1][1]); w.w = cvt_pk_bf16(S[2 * s + 1][2], S[2 * s + 1][3]); Sb[s] = __builtin_bit_cast(bf16x8, w); }
#pragma unroll
            for (int m = 0; m < 4; ++m)
#pragma unroll
                for (int s = 0; s < 2; ++s) vn[m] = __builtin_amdgcn_mfma_f32_16x16x32_bf16(fW[m][s], Sb[s], vn[m], 0, 0, 0);
            if (c >= 4) {
#pragma unroll
                for (int m = 0; m < 4; ++m) { fD[m][0] = *(const LAS bf16x8*)(sb + SC_MAT + m * 2048 + fo0); fD[m][1] = *(const LAS bf16x8*)(sb + SC_MAT + m * 2048 + fo1);
                    fK[m][0] = *(const LAS bf16x8*)(sb + 2 * SC_MAT + m * 2048 + fo0); fK[m][1] = *(const LAS bf16x8*)(sb + 2 * SC_MAT + m * 2048 + fo1); } }
#pragma unroll
            for (int m = 0; m < 4; ++m) { fW[m][0] = *(const LAS bf16x8*)(sb + 3 * SC_MAT + m * 2048 + fo0); fW[m][1] = *(const LAS bf16x8*)(sb + 3 * SC_MAT + m * 2048 + fo1); }
            __builtin_amdgcn_sched_barrier(0);
#pragma unroll
            for (int s = 0; s < 2; ++s) { u32x4 w; w.x = cvt_pk_bf16(vn[2 * s][0], vn[2 * s][1]); w.y = cvt_pk_bf16(vn[2 * s][2], vn[2 * s][3]); w.z = cvt_pk_bf16(vn[2 * s + 1][0], vn[2 * s + 1][1]); w.w = cvt_pk_bf16(vn[2 * s + 1][2], vn[2 * s + 1][3]); Vb[s] = __builtin_bit_cast(bf16x8, w); }
            if (c >= 4) {
#pragma unroll
                for (int m = 0; m < 4; ++m) { f32x4 o = (f32x4){0.f, 0.f, 0.f, 0.f};
#pragma unroll
                    for (int s = 0; s < 2; ++s) { o = __builtin_amdgcn_mfma_f32_16x16x32_bf16(fD[m][s], Sb[s], o, 0, 0, 0); o = __builtin_amdgcn_mfma_f32_16x16x32_bf16(fK[m][s], Vb[s], o, 0, 0, 0); }
                    opend[m] = o; }
            }
#pragma unroll
            for (int m = 0; m < 4; ++m) { S[m] = S[m] * gl;
#pragma unroll
                for (int s = 0; s < 2; ++s) S[m] = __builtin_amdgcn_mfma_f32_16x16x32_bf16(fW[m][s], Vb[s], S[m], 0, 0, 0); }
        }
        SC_STORE(DN_NCH - 1);
#undef SC_DMA
#undef SC_STORE
        asm volatile("s_waitcnt vmcnt(0)" ::: "memory"); __syncthreads();
        if (fold) dn_out_range(F, A, pair, 0, T);
        else if (F.tid == 0) { __builtin_amdgcn_fence(__ATOMIC_RELEASE, "agent"); asm volatile("s_waitcnt vmcnt(0)" ::: "memory");
            __hip_atomic_store((unsigned*)(F.ws + WS_CTL) + CW_FLAG + pair * 16, 1u, __ATOMIC_RELAXED, __HIP_MEMORY_SCOPE_AGENT); }
    }
}
__device__ __forceinline__ void dn_scan1(Frame& F, const Args& A, int seq) {
    const unsigned char* DNOP = F.ws + WS_DNOP; const float* GL = (const float*)(F.ws + WS_GL);
    const int lane = F.lane, g = lane >> 4, li = lane & 15, wave = F.wave, sl = wave & 3; const bool comp = wave < 4;
    unsigned srcl[2];
#pragma unroll
    for (int p = 0; p < 2; ++p) srcl[p] = (unsigned)(((lane & ~7) | ((lane & 7) ^ ((4 * p + (lane >> 4)) & 7))) * 16);
    const int xs = (li >> 1) & 7;
    const int fo0 = li * 128 + 16 * (g ^ xs), fo1 = li * 128 + 16 * ((4 + g) ^ xs);
    const int b = seq >> 4, h = (seq >> 1) & 7, d = seq & 1;
    f32x4 S[4];
#pragma unroll
    for (int m = 0; m < 4; ++m) S[m] = (f32x4){0.f, 0.f, 0.f, 0.f};
    const int sgn = d ? -1 : 1; const int obase_s = d * NT * 512 + b * T * 512;
    LAS bf16* oscr = (LAS bf16*)(F.lds + 4 * SC_SEQ + sl * 1024); bf16* OFB16 = (bf16*)(F.ws + WS_OF);
    const unsigned char* rec0 = DNOP + (size_t)seq * DN_NCH * DN_REC;
    const float glv = lane < DN_NCH ? GL[(size_t)seq * DN_NCH + lane] : 0.f;
    __syncthreads();
#ifndef S1_AUX
#define S1_AUX 2
#endif
#define S1_DMA(cn) do { const int _cn = (cn) < DN_NCH ? (cn) : DN_NCH - 1; const unsigned char* _rn = rec0 + (size_t)_cn * DN_REC; LAS unsigned char* _db = F.lds + ((cn) & 3) * SC_SEQ + wave * 4096; \
        _Pragma("unroll") for (int _i = 0; _i < 4; ++_i) { unsigned _vo = srcl[_i & 1]; asm volatile("" : "+v"(_vo)); __builtin_amdgcn_global_load_lds((const unsigned*)(_rn + (wave * 4 + _i) * 1024 + _vo), (LAS unsigned*)(_db + _i * 1024), 16, 0, S1_AUX); } } while (0)
#define S1_ULD(cn, pu) do { const int _cn = (cn) < DN_NCH ? (cn) : DN_NCH - 1; const unsigned char* _up = rec0 + (size_t)_cn * DN_REC + 32768 + (sl * 64 + lane) * 32; \
        asm volatile("global_load_dwordx4 %0, %2, off nt\n\tglobal_load_dwordx4 %1, %2, off offset:16 nt" : "+v"(pu##0), "+v"(pu##1) : "v"(_up) : "memory"); } while (0)
#define S1_STORE(cp) do { const int _tok0 = d ? (64 * (31 - ((cp) - 4)) + 63) : 64 * ((cp) - 4); _Pragma("unroll") for (int _hf = 0; _hf < 2; ++_hf) { \
            _Pragma("unroll") for (int _m = 0; _m < 2; ++_m) _Pragma("unroll") for (int _r = 0; _r < 4; ++_r) oscr[(16 * _m + 4 * g + _r) * 16 + li] = (bf16)f2bf(opend[2 * _hf + _m][_r]); \
            LDS_WAIT(); asm volatile("" ::: "memory"); const u32x4 _v = *(const LAS u32x4*)(oscr + (lane >> 1) * 16 + (lane & 1) * 8); LDS_WAIT(); asm volatile("" ::: "memory"); \
            *(u32x4*)(OFB16 + (size_t)obase_s + (size_t)(_tok0 + (32 * _hf + (lane >> 1)) * sgn) * 512 + h * 64 + 16 * sl + (lane & 1) * 8) = _v; } } while (0)
    u32x4 puA0 = (u32x4){0u, 0u, 0u, 0u}, puA1 = puA0, puB0 = puA0, puB1 = puA0, puC0 = puA0, puC1 = puA0;
    S1_DMA(0); S1_DMA(1); S1_DMA(2);
    if (comp) { S1_ULD(0, puA); S1_ULD(1, puB); S1_ULD(2, puC); }
#define S1_STEP(c, pu) do { \
        if (comp) { if ((c) >= 7) asm volatile("s_waitcnt vmcnt(18)" ::: "memory"); else if ((c) == 6) asm volatile("s_waitcnt vmcnt(16)" ::: "memory"); else if ((c) == 5) asm volatile("s_waitcnt vmcnt(14)" ::: "memory"); \
            else if ((c) >= 2) asm volatile("s_waitcnt vmcnt(12)" ::: "memory"); else if ((c) == 1) asm volatile("s_waitcnt vmcnt(8)" ::: "memory"); else asm volatile("s_waitcnt vmcnt(4)" ::: "memory"); } \
        else asm volatile("s_waitcnt vmcnt(8)" ::: "memory"); \
        asm volatile("s_waitcnt lgkmcnt(0)" ::: "memory"); __builtin_amdgcn_s_barrier(); asm volatile("" ::: "memory");     \
        S1_DMA((c) + 3); \
        if (comp) { \
            const float gl = __builtin_bit_cast(float, __builtin_amdgcn_readlane(__builtin_bit_cast(int, glv), (c))); \
            f32x4 vn[4]; \
            vn[0] = (f32x4){bf2f((pu##0).x & 0xffffu), bf2f((pu##0).x >> 16), bf2f((pu##0).y & 0xffffu), bf2f((pu##0).y >> 16)}; vn[1] = (f32x4){bf2f((pu##0).z & 0xffffu), bf2f((pu##0).z >> 16), bf2f((pu##0).w & 0xffffu), bf2f((pu##0).w >> 16)}; \
            vn[2] = (f32x4){bf2f((pu##1).x & 0xffffu), bf2f((pu##1).x >> 16), bf2f((pu##1).y & 0xffffu), bf2f((pu##1).y >> 16)}; vn[3] = (f32x4){bf2f((pu##1).z & 0xffffu), bf2f((pu##1).z >> 16), bf2f((pu##1).w & 0xffffu), bf2f((pu##1).w >> 16)}; \
            asm volatile("" : "+v"(vn[0]), "+v"(vn[1]), "+v"(vn[2]), "+v"(vn[3])); __builtin_amdgcn_sched_barrier(0); \
            S1_ULD((c) + 3, pu); \
            const LAS unsigned char* sb = F.lds + ((c) & 3) * SC_SEQ; \
            bf16x8 fW[4][2], fD[4][2]; \
            _Pragma("unroll") for (int m = 0; m < 4; ++m) { fW[m][0] = *(const LAS bf16x8*)(sb + m * 2048 + fo0); fW[m][1] = *(const LAS bf16x8*)(sb + m * 2048 + fo1); } \
            __builtin_amdgcn_sched_barrier(0); \
            bf16x8 Sb[2], Vb[2]; \
            _Pragma("unroll") for (int s = 0; s < 2; ++s) { u32x4 w; w.x = cvt_pk_bf16(S[2 * s][0], S[2 * s][1]); w.y = cvt_pk_bf16(S[2 * s][2], S[2 * s][3]); w.z = cvt_pk_bf16(S[2 * s + 1][0], S[2 * s + 1][1]); w.w = cvt_pk_bf16(S[2 * s + 1][2], S[2 * s + 1][3]); Sb[s] = __builtin_bit_cast(bf16x8, w); } \
            _Pragma("unroll") for (int m = 0; m < 4; ++m) _Pragma("unroll") for (int s = 0; s < 2; ++s) vn[m] = __builtin_amdgcn_mfma_f32_16x16x32_bf16(fW[m][s], Sb[s], vn[m], 0, 0, 0); \
            __builtin_amdgcn_sched_barrier(0); \
            _Pragma("unroll") for (int m = 0; m < 4; ++m) { fW[m][0] = *(const LAS bf16x8*)(sb + 3 * SC_MAT + m * 2048 + fo0); fW[m][1] = *(const LAS bf16x8*)(sb + 3 * SC_MAT + m * 2048 + fo1); } \
            if ((c) >= 4) { _Pragma("unroll") for (int m = 0; m < 4; ++m) { fD[m][0] = *(const LAS bf16x8*)(sb + SC_MAT + m * 2048 + fo0); fD[m][1] = *(const LAS bf16x8*)(sb + SC_MAT + m * 2048 + fo1); } } \
            __builtin_amdgcn_sched_barrier(0); \
            _Pragma("unroll") for (int s = 0; s < 2; ++s) { u32x4 w; w.x = cvt_pk_bf16(vn[2 * s][0], vn[2 * s][1]); w.y = cvt_pk_bf16(vn[2 * s][2], vn[2 * s][3]); w.z = cvt_pk_bf16(vn[2 * s + 1][0], vn[2 * s + 1][1]); w.w = cvt_pk_bf16(vn[2 * s + 1][2], vn[2 * s + 1][3]); Vb[s] = __builtin_bit_cast(bf16x8, w); } \
            _Pragma("unroll") for (int m = 0; m < 4; ++m) { S[m] = S[m] * gl; \
                _Pragma("unroll") for (int s = 0; s < 2; ++s) S[m] = __builtin_amdgcn_mfma_f32_16x16x32_bf16(fW[m][s], Vb[s], S[m], 0, 0, 0); } \
            __builtin_amdgcn_sched_barrier(0); \
            if ((c) >= 4) { \
                _Pragma("unroll") for (int m = 0; m < 4; ++m) { fW[m][0] = *(const LAS bf16x8*)(sb + 2 * SC_MAT + m * 2048 + fo0); fW[m][1] = *(const LAS bf16x8*)(sb + 2 * SC_MAT + m * 2048 + fo1); } \
                f32x4 opend[4]; \
                _Pragma("unroll") for (int m = 0; m < 4; ++m) { f32x4 o = (f32x4){0.f, 0.f, 0.f, 0.f}; \
                    _Pragma("unroll") for (int s = 0; s < 2; ++s) o = __builtin_amdgcn_mfma_f32_16x16x32_bf16(fD[m][s], Sb[s], o, 0, 0, 0); opend[m] = o; } \
                __builtin_amdgcn_sched_barrier(0); \
                _Pragma("unroll") for (int m = 0; m < 4; ++m) _Pragma("unroll") for (int s = 0; s < 2; ++s) opend[m] = __builtin_amdgcn_mfma_f32_16x16x32_bf16(fW[m][s], Vb[s], opend[m], 0, 0, 0); \
                S1_STORE(c); } \
        } } while (0)
#pragma unroll 1
    for (int c0 = 0; c0 < DN_NCH; c0 += 3) { S1_STEP(c0, puA); S1_STEP(c0 + 1, puB); S1_STEP(c0 + 2, puC); }
#undef S1_STEP
#undef S1_DMA
#undef S1_ULD
#undef S1_STORE
    asm volatile("s_waitcnt vmcnt(0)" : "+v"(puA0), "+v"(puA1), "+v"(puB0), "+v"(puB1), "+v"(puC0), "+v"(puC1) :: "memory");
    __syncthreads();
    if (F.tid == 0) { __builtin_amdgcn_fence(__ATOMIC_RELEASE, "agent"); asm volatile("s_waitcnt vmcnt(0)" ::: "memory");
        __hip_atomic_fetch_add((unsigned*)(F.ws + WS_CTL) + CW_FLAG + (seq >> 1) * 16, 1u, __ATOMIC_RELAXED, __HIP_MEMORY_SCOPE_AGENT); }
}
__device__ __forceinline__ void dn_out(Frame& F, const Args& A) {
    const float* OF = (const float*)(F.ws + WS_OF); const float* OB = OF + (size_t)NT * 512; const bf16* PJ = (const bf16*)(F.ws + WS_PROJ); bf16* OC = (bf16*)(F.ws + WS_OCAT); const float* nw = A.in[12];
    for (size_t it = (size_t)blockIdx.x * NTHR + F.tid; it < (size_t)NT * 64; it += (size_t)F.G * NTHR) {
        const size_t tok = it >> 6; const int hc = (int)(it & 63);
        const f32x4 a0 = *(const f32x4*)(OF + tok * 512 + hc * 8), a1 = *(const f32x4*)(OF + tok * 512 + hc * 8 + 4), b0 = *(const f32x4*)(OB + tok * 512 + hc * 8), b1 = *(const f32x4*)(OB + tok * 512 + hc * 8 + 4);
        float v[8]; float ss = 0.f;
#pragma unroll
        for (int e = 0; e < 4; ++e) { v[e] = a0[e] + b0[e]; v[4 + e] = a1[e] + b1[e]; }
#pragma unroll
        for (int e = 0; e < 8; ++e) ss += v[e] * v[e];
        ss += __shfl_xor(ss, 1); ss += __shfl_xor(ss, 2); ss += __shfl_xor(ss, 4);
        const float rstd = rsqrtf(ss * (1.f / 64.f) + EPS);
        const u32x4 gw = *(const u32x4*)(PJ + tok * NPROJ + P_DG + hc * 8); const f32x4 w0 = *(const f32x4*)(nw + (hc & 7) * 8), w1 = *(const f32x4*)(nw + (hc & 7) * 8 + 4);
        float o[8];
#pragma unroll
        for (int e = 0; e < 8; ++e) { const float z = bf2f(e & 1 ? gw[e >> 1] >> 16 : gw[e >> 1] & 0xffffu); const float wv = e < 4 ? w0[e] : w1[e - 4]; o[e] = v[e] * rstd * wv * (z * __builtin_amdgcn_rcpf(1.f + __expf(-z))); }
        u32x4 w; w.x = pk2(o[0], o[1]); w.y = pk2(o[2], o[3]); w.z = pk2(o[4], o[5]); w.w = pk2(o[6], o[7]);
        *(u32x4*)(OC + tok * D + 512 + hc * 8) = w;
    }
}
__global__ void __launch_bounds__(NTHR, 2) mk_fwd(const Args args) {
    extern __shared__ __attribute__((aligned(16))) unsigned char lds_raw[];
    Frame F;
    F.lds = (LAS unsigned char*)lds_raw; F.ws = args.ws;
    F.tid = threadIdx.x; F.lane = F.tid & 63; F.wave = __builtin_amdgcn_readfirstlane(F.tid >> 6);
    F.G = gridDim.x; { const int bx = blockIdx.x; F.vcu = (F.G % 8 == 0) ? (bx % 8) * (F.G / 8) + bx / 8 : bx; }
    volatile LAS unsigned* MISC = (volatile LAS unsigned*)(F.lds + MISC_OFF);
    volatile LAS int* mts = (volatile LAS int*)(F.lds + MISC_OFF + 256);
    for (int u = F.tid; u < 1024; u += NTHR) MISC[u] = 0u;
    __syncthreads();
    const int lo = args.ph_lo, hi = args.ph_hi;
    unsigned* ctl = (unsigned*)(args.ws + WS_CTL);
    XcdBarrier bar; bar.bar = ctl + CW_BAR; bar.x = 0; bar.st = MISC + 8;
    if (hi - lo > 1) bar = xcd_barrier_post(ctl + CW_BAR, MISC + 8);
    unsigned char* ws = args.ws;
#define IN(k) (frame_refresh(F), (lo <= (k) && (k) < hi))
#define SEAM(k) do { if (IN(k) && IN((k) + 1)) xcd_barrier(bar, F.wave); } while (0)
#if !defined(PH_MASK) || (PH_MASK & (1 << 0))
    if (IN(0)) { p0_prologue(F, args); } SEAM(0);
#endif
#if !defined(PH_MASK) || (PH_MASK & (1 << 1))
    if (IN(1)) { norm_skinny<0, 2>(F, args, 0, NT / 64, true); frame_refresh(F); norm_skinny<0, 8>(F, args, NT, NC / 8, false); } SEAM(1);
#endif
#if !defined(PH_MASK) || (PH_MASK & (1 << 2))
    if (IN(2)) { ProbProj P{(const bf16*)(ws + WS_H), (const bf16*)(ws + WS_WIN), (bf16*)(ws + WS_PROJ), F.G, (int)blockIdx.x}; gemm_phase(F.lds, P, F.wave);
        ProbProjG8 Q{F.ws + WS_HG8, F.ws + WS_WG8, (bf16*)(ws + WS_PROJ), F.G, (int)blockIdx.x}; gemm_phase(F.lds, Q, F.wave); } SEAM(2);
#endif
#if !defined(PH_MASK) || (PH_MASK & (1 << 3))
    if (IN(3)) { dn_prep(F, args); } SEAM(3);
#endif
#if !defined(PH_MASK) || (PH_MASK & (1 << 4))
    if (IN(4)) {
        if (F.G == 256) {
            const int bx = (int)blockIdx.x; constexpr int NA_WS = 4, NA_WN = 10;
            if (bx < 128) { dn_scan1(F, args, bx); frame_refresh(F); }
            const int wlo = bx < 128 ? bx * NA_WS : 128 * NA_WS + (bx - 128) * NA_WN, whi = wlo + (bx < 128 ? NA_WS : NA_WN);
            na_phase(F, args, 0, 1, wlo, whi, NB * H * 32, 128 * (NA_WS + NA_WN)); frame_refresh(F);
            dn_out_items(F, args, bx, 256, 4, 2u); }
        else { dn_scan(F, args, (int)blockIdx.x, F.G, true); frame_refresh(F); na_phase(F, args, (int)blockIdx.x, F.G); }
        } SEAM(4);
#endif
#if !defined(PH_MASK) || (PH_MASK & (1 << 5))
    (void)0;
#endif
#if !defined(PH_MASK) || (PH_MASK & (1 << 6))
    if (IN(6)) { ProbE1 P{ws + WS_OCAT, ws + WS_WBR, (const bf16*)(ws + WS_PROJ), ws + WS_Y1, F.G, (int)blockIdx.x}; gemm_phase(F.lds, P, F.wave); } SEAM(6);
#endif
#if !defined(PH_MASK) || (PH_MASK & (1 << 7))
    if (IN(7)) { ProbE2 P{ws + WS_Y1, ws + WS_WOUT, args.in[0], (const float*)(ws + WS_MOD), (bf16*)(ws + WS_OF), F.G, (int)blockIdx.x}; gemm_phase(F.lds, P, F.wave); } SEAM(7);
#endif
#if !defined(PH_MASK) || (PH_MASK & (1 << 8))
    if (IN(8)) { norm_skinny<1, 2>(F, args, 0, NT / 64, true); } SEAM(8);
#endif
#if !defined(PH_MASK) || (PH_MASK & (1 << 9))
    if (IN(9)) { moe_tile_starts(F, mts);
        ProbMoe1 P{(const unsigned char*)(ws + WS_H), (const unsigned char*)(ws + WS_W1), (unsigned char*)(ws + WS_ACT), args.in[20], (const int*)(ws + WS_TOKL), (const unsigned*)(ws + WS_CTL) + CW_CNT, mts, F.G, (int)blockIdx.x, __builtin_amdgcn_readfirstlane(mts[E])}; gemm_phase(F.lds, P, F.wave); } SEAM(9);
#endif
#if !defined(PH_MASK) || (PH_MASK & (1 << 10))
    if (IN(10)) { moe_tile_starts(F, mts);
        ProbMoe2 P{(const unsigned char*)(ws + WS_ACT), (const unsigned char*)(ws + WS_W2), (unsigned char*)(ws + WS_Y2), args.in[22], (const float*)(ws + WS_GATEL), (const unsigned*)(ws + WS_CTL) + CW_CNT, mts, F.G, (int)blockIdx.x, __builtin_amdgcn_readfirstlane(mts[E])}; gemm_phase(F.lds, P, F.wave); } SEAM(10);
#endif
#if !defined(PH_MASK) || (PH_MASK & (1 << 11))
    if (IN(11)) { moe_tile_starts(F, mts); final_phase(F, args, mts); }
#endif
#undef IN
#undef SEAM
}
}

extern "C" void kernel_launch(void* const* d_in, const int* in_sizes, int n_in, void* d_out, int out_size, void* d_ws, size_t ws_size, hipStream_t stream) {
    static int grid = 0;
    if (grid == 0) {
        int dev = 0, cus = 0; (void)hipGetDevice(&dev); (void)hipDeviceGetAttribute(&cus, hipDeviceAttributeMultiprocessorCount, dev);
        (void)hipFuncSetAttribute((const void*)mk::mk_fwd, hipFuncAttributeMaxDynamicSharedMemorySize, mk::LDS_BYTES);
        grid = cus > 0 ? cus : 256;
        if (ws_size < mk::WS_END || n_in != 24) { fprintf(stderr, "kernel_launch: ws too small (%zu) or bad n_in %d\n", ws_size, n_in); grid = -1; }
    }
    if (grid < 0) return;
    (void)hipMemsetAsync((char*)d_ws + mk::WS_CTL, 0, mk::CTL_BYTES, stream);
    mk::Args a{};
    for (int i = 0; i < 24; ++i) a.in[i] = (const float*)d_in[i];
    a.out = (float*)d_out; a.ws = (unsigned char*)d_ws;
    a.ph_lo = 0; a.ph_hi = 12; hipLaunchKernelGGL(mk::mk_fwd, dim3(grid), dim3(mk::NTHR), mk::LDS_BYTES, stream, a);
}
```
